# Optimizing an MI355X kernel written in HIP

```python
import jax, jax.numpy as jnp
from jax import lax
import numpy as np

D_MODEL = 2048
BATCH = 8
SEQ = 2048
DEPTH = 1

CTX_LEN = 256
GRID_W = 64
Q_BLOCK = 128
ROPE_THETA = 10000.0
NORM_EPS = 1e-6

MLA_HEADS = 8
MLA_Q_LORA = 768
MLA_KV_LORA = 512
MLA_NOPE = 128
MLA_ROPE = 64
MLA_V = 128
GQA_HEADS = 8
GQA_KV_HEADS = 2
GQA_HEAD_DIM = 128
D_FF = 5632
CONV_W = 3
N_BRANCH = 2

KV_COLS = MLA_KV_LORA + MLA_ROPE + 2 * GQA_KV_HEADS * GQA_HEAD_DIM
Q_COLS = MLA_Q_LORA + GQA_HEADS * GQA_HEAD_DIM
GATE_COLS = N_BRANCH * D_MODEL
IN_COLS = KV_COLS + Q_COLS + GATE_COLS
KV_SPLITS = [MLA_KV_LORA, MLA_KV_LORA + MLA_ROPE, MLA_KV_LORA + MLA_ROPE + GQA_KV_HEADS * GQA_HEAD_DIM]

kernel_name = "hybrid_mla_gqa_convffn_dit_prefix"


def rms_norm(x, g):
    xf = x.astype(jnp.float32)
    y = xf * lax.rsqrt(jnp.mean(xf * xf, axis=-1, keepdims=True) + NORM_EPS)
    return (y * g.astype(jnp.float32)).astype(x.dtype)


def modulate(h, shift, scale):
    return h * (1 + scale) + shift


def ada_terms(cond, w_ada, b_ada):
    return jnp.split(jax.nn.silu(cond) @ w_ada + b_ada, 6, axis=-1)


def grid_rope_tables(n_rows, rot_dim):
    row = jnp.repeat(jnp.arange(n_rows, dtype=jnp.float32), GRID_W)
    col = jnp.tile(jnp.arange(GRID_W, dtype=jnp.float32), n_rows)
    half = rot_dim // 2
    inv_freq = ROPE_THETA ** (-jnp.arange(0, half, 2, dtype=jnp.float32) / half)
    ang = jnp.concatenate([row[:, None] * inv_freq, col[:, None] * inv_freq], axis=-1)
    return jnp.cos(ang), jnp.sin(ang)


def apply_grid_rope(x, cos, sin):
    b, t, h, r = x.shape
    q = r // 4
    xs = x.reshape(b, t, h, 2, 2, q)
    x1, x2 = xs[..., 0, :], xs[..., 1, :]
    c = cos.reshape(t, 1, 2, q).astype(x.dtype)
    s = sin.reshape(t, 1, 2, q).astype(x.dtype)
    out = jnp.stack([x1 * c - x2 * s, x1 * s + x2 * c], axis=-2)
    return out.reshape(b, t, h, r)


def block_attention(q, k, v):
    b, tq, hk, g, dk = q.shape
    dv = v.shape[-1]
    scale = dk ** -0.5
    kf = k.astype(jnp.float32)
    qb = jnp.moveaxis(q.reshape(b, tq // Q_BLOCK, Q_BLOCK, hk, g, dk), 1, 0)

    def one_block(q_blk):
        s = jnp.einsum("bqhgd,bkhd->bhgqk", q_blk.astype(jnp.float32), kf) * scale
        p = jax.nn.softmax(s, axis=-1)
        return jnp.einsum("bhgqk,bkhd->bqhgd", p.astype(v.dtype), v)

    o = lax.map(one_block, qb)
    return jnp.moveaxis(o, 0, 1).reshape(b, tq, hk * g * dv)


def mixer_keys(kv, p, rope):
    b, t, _ = kv.shape
    c_kv, k_pe, k_b, v_b = jnp.split(kv, KV_SPLITS, axis=-1)
    kv_up = (rms_norm(c_kv, p["mla_kv_norm_g"]) @ p["w_kv_up"]).reshape(b, t, MLA_HEADS, MLA_NOPE + MLA_V)
    k_nope, v_a = jnp.split(kv_up, [MLA_NOPE], axis=-1)
    k_pe = k_pe.reshape(b, t, 1, MLA_ROPE)
    k_b = rms_norm(k_b.reshape(b, t, GQA_KV_HEADS, GQA_HEAD_DIM), p["gqa_k_norm_g"])
    v_b = v_b.reshape(b, t, GQA_KV_HEADS, GQA_HEAD_DIM)
    if rope is not None:
        cos_a, sin_a, cos_b, sin_b = rope
        k_pe = apply_grid_rope(k_pe, cos_a, sin_a)
        k_b = apply_grid_rope(k_b, cos_b, sin_b)
    k_a = jnp.concatenate([k_nope, jnp.broadcast_to(k_pe, (b, t, MLA_HEADS, MLA_ROPE))], axis=-1)
    return (k_a, v_a, k_b, v_b)


def mixer_queries(qp, p, rope):
    b, t, _ = qp.shape
    c_q, q_b = jnp.split(qp, [MLA_Q_LORA], axis=-1)
    q_a = (rms_norm(c_q, p["mla_q_norm_g"]) @ p["w_q_up"]).reshape(b, t, MLA_HEADS, MLA_NOPE + MLA_ROPE)
    q_nope, q_pe = jnp.split(q_a, [MLA_NOPE], axis=-1)
    q_b = rms_norm(q_b.reshape(b, t, GQA_HEADS, GQA_HEAD_DIM), p["gqa_q_norm_g"])
    if rope is not None:
        cos_a, sin_a, cos_b, sin_b = rope
        q_pe = apply_grid_rope(q_pe, cos_a, sin_a)
        q_b = apply_grid_rope(q_b, cos_b, sin_b)
    q_a = jnp.concatenate([q_nope, q_pe], axis=-1)[:, :, :, None, :]
    q_b = q_b.reshape(b, t, GQA_KV_HEADS, GQA_HEADS // GQA_KV_HEADS, GQA_HEAD_DIM)
    return q_a, q_b


def attend_and_merge(proj, keys, p, rope):
    q_a, q_b = mixer_queries(proj[..., KV_COLS:KV_COLS + Q_COLS], p, rope)
    g_a, g_b = jnp.split(jax.nn.sigmoid(proj[..., KV_COLS + Q_COLS:]), N_BRANCH, axis=-1)
    k_a, v_a, k_b, v_b = keys
    o_a = block_attention(q_a, k_a, v_a)
    o_b = block_attention(q_b, k_b, v_b)
    merged = g_a * (o_a @ p["w_br_a"]) + g_b * (o_b @ p["w_br_b"])
    return merged @ p["w_out"]


def conv_ffn(z, p):
    t = z.shape[1]
    u = z @ p["w_up"]
    pad = CONV_W // 2
    up = jnp.pad(u, ((0, 0), (pad, pad), (0, 0)))
    uc = p["conv_b"] + sum(p["conv_w"][j] * up[:, j:j + t] for j in range(CONV_W))
    a, bb = jnp.split(uc, 2, axis=-1)
    return (jax.nn.silu(a) * bb) @ p["w_down"]


def setup_inputs(seed: int = 0) -> dict:
    key = jax.random.key(seed)
    ks = jax.random.split(key, 24)
    f32 = jnp.float32

    def nrm(k, shape, scale):
        return jax.random.normal(k, shape, f32) * scale

    def gain(k, shape):
        return 1.0 + 0.01 * jax.random.normal(k, shape, f32)

    L, D = DEPTH, D_MODEL
    return {
        "x": nrm(ks[0], (BATCH, SEQ, D), 1.0),
        "c": nrm(ks[1], (BATCH, D), 1.0),
        "ctx": nrm(ks[2], (BATCH, CTX_LEN, D), 1.0),
        "c_ctx": nrm(ks[3], (D,), 0.5),
        "w_ada": nrm(ks[4], (L, D, 6 * D), 0.5 * D ** -0.5),
        "b_ada": nrm(ks[5], (L, 6 * D), 0.01),
        "norm1_g": gain(ks[6], (L, D)),
        "w_in": nrm(ks[7], (L, D, IN_COLS), D ** -0.5),
        "mla_q_norm_g": gain(ks[8], (L, MLA_Q_LORA)),
        "w_q_up": nrm(ks[9], (L, MLA_Q_LORA, MLA_HEADS * (MLA_NOPE + MLA_ROPE)), MLA_Q_LORA ** -0.5),
        "mla_kv_norm_g": gain(ks[10], (L, MLA_KV_LORA)),
        "w_kv_up": nrm(ks[11], (L, MLA_KV_LORA, MLA_HEADS * (MLA_NOPE + MLA_V)), MLA_KV_LORA ** -0.5),
        "gqa_q_norm_g": gain(ks[12], (L, GQA_HEAD_DIM)),
        "gqa_k_norm_g": gain(ks[13], (L, GQA_HEAD_DIM)),
        "w_br_a": nrm(ks[14], (L, MLA_HEADS * MLA_V, D), (MLA_HEADS * MLA_V) ** -0.5),
        "w_br_b": nrm(ks[15], (L, GQA_HEADS * GQA_HEAD_DIM, D), (GQA_HEADS * GQA_HEAD_DIM) ** -0.5),
        "w_out": nrm(ks[16], (L, D, D), D ** -0.5),
        "norm2_g": gain(ks[17], (L, D)),
        "w_up": nrm(ks[18], (L, D, 2 * D_FF), D ** -0.5),
        "conv_w": nrm(ks[19], (L, CONV_W, 2 * D_FF), CONV_W ** -0.5),
        "conv_b": nrm(ks[20], (L, 2 * D_FF), 0.01),
        "w_down": nrm(ks[21], (L, D_FF, D), D_FF ** -0.5),
        "final_norm_g": gain(ks[22], (D,)),
    }


def reference(x, c, ctx, c_ctx, w_ada, b_ada, norm1_g, w_in, mla_q_norm_g, w_q_up, mla_kv_norm_g,
              w_kv_up, gqa_q_norm_g, gqa_k_norm_g, w_br_a, w_br_b, w_out, norm2_g, w_up, conv_w,
              conv_b, w_down, final_norm_g):
    n_lat = x.shape[1]
    ROWS = n_lat // GRID_W
    rope = (*grid_rope_tables(ROWS, MLA_ROPE), *grid_rope_tables(ROWS, GQA_HEAD_DIM))
    cond_lat = c[:, None, :]
    cond_ctx = c_ctx[None, None, :]

    for l in range(DEPTH):
        p = {
            "w_in": w_in[l], "mla_q_norm_g": mla_q_norm_g[l], "w_q_up": w_q_up[l],
            "mla_kv_norm_g": mla_kv_norm_g[l], "w_kv_up": w_kv_up[l],
            "gqa_q_norm_g": gqa_q_norm_g[l], "gqa_k_norm_g": gqa_k_norm_g[l],
            "w_br_a": w_br_a[l], "w_br_b": w_br_b[l], "w_out": w_out[l],
            "w_up": w_up[l], "conv_w": conv_w[l], "conv_b": conv_b[l], "w_down": w_down[l],
        }
        last = l == DEPTH - 1
        sh1, sc1, g1, sh2, sc2, g2 = ada_terms(cond_lat, w_ada[l], b_ada[l])
        ctx_terms = ada_terms(cond_ctx, w_ada[l], b_ada[l])

        z_ctx = modulate(rms_norm(ctx, norm1_g[l]), ctx_terms[0], ctx_terms[1])
        ctx_proj = z_ctx @ (p["w_in"][:, :KV_COLS] if last else p["w_in"])
        ctx_keys = mixer_keys(ctx_proj[..., :KV_COLS], p, None)

        z_lat = modulate(rms_norm(x, norm1_g[l]), sh1, sc1)
        lat_proj = z_lat @ p["w_in"]
        lat_keys = mixer_keys(lat_proj[..., :KV_COLS], p, rope)
        keys = tuple(jnp.concatenate([ck, lk], axis=1) for ck, lk in zip(ctx_keys, lat_keys))
        x = x + g1 * attend_and_merge(lat_proj, keys, p, rope)
        x = x + g2 * conv_ffn(modulate(rms_norm(x, norm2_g[l]), sh2, sc2), p)

        if not last:
            ctx = ctx + ctx_terms[2] * attend_and_merge(ctx_proj, ctx_keys, p, None)
            z2 = modulate(rms_norm(ctx, norm2_g[l]), ctx_terms[3], ctx_terms[4])
            ctx = ctx + ctx_terms[5] * conv_ffn(z2, p)

    return rms_norm(x, final_norm_g)
```

```cpp
#include <hip/hip_runtime.h>
#include <hip/hip_cooperative_groups.h>
#include <cstdio>
#include <cstdint>
namespace cg = cooperative_groups;
namespace pg8 {
#define PG8_LAS __attribute__((address_space(3)))
typedef unsigned short bf16_t;
typedef short bf16x8 __attribute__((ext_vector_type(8)));
typedef float f32x4 __attribute__((ext_vector_type(4)));
typedef unsigned u32x4 __attribute__((ext_vector_type(4)));
constexpr int BM = 256, BK = 64, HALF = 128, HTB = HALF * BK * 2  , STAGE_BYTES = 8 * HTB, NXCD = 8, WGM = 8;

__host__ __device__ __forceinline__ int lds_byte(int r, int c) { const int st = (r >> 4) * 2 + (c >> 5), rr = r & 15, cc = c & 31, ob = rr * 64 + cc * 2; return st * 1024 + (ob ^ (((ob >> 9) & 1) << 5)); }
__host__ __device__ __forceinline__ void stage_rc(int b, int& R, int& C) { const int st = b / 1024, sb = b % 1024, swz = sb ^ (((sb >> 9) & 1) << 5); R = (st >> 1) * 16 + swz / 64; C = (st & 1) * 32 + (swz % 64) / 2; }
__host__ __device__ __forceinline__ int perm32(int rho) { const int n = rho >> 4, i = rho & 15; return 8 * (i >> 2) + 4 * n + (i & 3); }

struct Unit { int pm, pn; };
struct Gemm { const bf16_t* A; const bf16_t* Bt; int M, N, K; };

struct StaticOrder {
    int nM, nN, nwg, G, c;
    __host__ __device__ void init(int M, int N, int G_, int c_) { nM = M / BM; nN = N / BM; nwg = nM * nN; G = G_; c = c_; }
    __host__ __device__ bool next(int i, Unit& u) const {
        const long L = (long)i * G + c; if (L >= nwg) return false;
        int wgid = (int)L; { const int q = nwg / NXCD, r = nwg % NXCD, xcd = wgid % NXCD, off = wgid / NXCD; wgid = (xcd < r ? xcd * (q + 1) : r * (q + 1) + (xcd - r) * q) + off; }
        const int nig = WGM * nN, gid = wgid / nig, fm = gid * WGM, gsz = (nM - fm) < WGM ? (nM - fm) : WGM;
        u.pm = fm + ((wgid % nig) % gsz); u.pn = (wgid % nig) / gsz; return true;
    }
    __device__ __forceinline__ void a_ready(const Unit&) const {}
    __device__ __forceinline__ void done(const Unit&) const {}
};

__device__ __forceinline__ unsigned cvt_pk_bf16(float lo, float hi) { unsigned r; asm volatile("v_cvt_pk_bf16_f32 %0, %1, %2" : "=v"(r) : "v"(lo), "v"(hi)); return r; }
typedef float f32x2 __attribute__((ext_vector_type(2)));
}
namespace pg8 {
__device__ __forceinline__ float bf2f(unsigned short h) { return __uint_as_float((unsigned)h << 16); }
__device__ __forceinline__ float bflo(unsigned w) { return __uint_as_float(w << 16); }
__device__ __forceinline__ float bfhi(unsigned w) { return __uint_as_float(w & 0xffff0000u); }
struct EpiPlain {
    static constexpr bool PERM = true, AFTER_DRAIN = false, HAS_MID = false;
    bf16_t* O; int ldc;
    __device__ __forceinline__ void operator()(const f32x4 (&acc)[2][2][4][2], const Unit& u, int wr, int wc, int fr, int fq) const {
        const int row0 = u.pm * BM + wr * 64 + fr, col0 = u.pn * BM + wc * 32 + 8 * fq;
#pragma unroll
        for (int ai = 0; ai < 2; ++ai)
#pragma unroll
            for (int m = 0; m < 4; ++m) { bf16_t* rowp = O + (size_t)(row0 + ai * HALF + m * 16) * ldc + col0;
#pragma unroll
                for (int bj = 0; bj < 2; ++bj) { const f32x4 v0 = acc[ai][bj][m][0], v1 = acc[ai][bj][m][1];
                    u32x4 w; w.x = cvt_pk_bf16(v0[0], v0[1]); w.y = cvt_pk_bf16(v0[2], v0[3]); w.z = cvt_pk_bf16(v1[0], v1[1]); w.w = cvt_pk_bf16(v1[2], v1[3]);
                    *(u32x4*)(rowp + bj * HALF) = w; } }
    }
};
struct EpiProj {
    static constexpr bool PERM = true, AFTER_DRAIN = false, HAS_MID = false;
    bf16_t *ckv, *kb, *vb, *kpe, *cq, *qb, *gates;
    __device__ __forceinline__ void operator()(const f32x4 (&acc)[2][2][4][2], const Unit& u, int wr, int wc, int fr, int fq) const {
        const int pn = u.pn, bb = u.pm / 9, jj = u.pm - bb * 9;
        const int rowz0 = u.pm * BM, rowl0 = (bb * 8 + jj - 1) * BM;
        bf16_t* base; int ld, row0, maxcol = 256; bool sig = false;
        if (pn < 2)       { base = ckv + pn * 256; ld = 512; row0 = rowz0; }
        else if (pn == 2) { base = kb; ld = 256; row0 = rowz0; }
        else if (pn == 3) { base = vb; ld = 256; row0 = rowz0; }
        else if (pn == 4) { base = kpe; ld = 64; row0 = rowz0; maxcol = 64; }
        else if (pn < 8)  { base = cq + (pn - 5) * 256; ld = 768; row0 = rowl0; }
        else if (pn < 12) { base = qb + (pn - 8) * 256; ld = 1024; row0 = rowl0; }
        else              { base = gates + (pn - 12) * 256; ld = 4096; row0 = rowl0; sig = true; }
        row0 += wr * 64 + fr; const int col0 = wc * 32 + 8 * fq;
        if (sig) {
            bf16_t* gbase = gates + (pn - 12) * 128 + col0;
#pragma unroll
            for (int ai = 0; ai < 2; ++ai)
#pragma unroll
                for (int m = 0; m < 4; ++m) { bf16_t* rowp = gbase + (size_t)(row0 + ai * HALF + m * 16) * 4096; f32x4 rt[2], gb[2];
#pragma unroll
                    for (int n = 0; n < 2; ++n)
#pragma unroll
                        for (int e = 0; e < 4; ++e) { const float ea = __builtin_amdgcn_exp2f(-1.4426950408889634f * acc[ai][0][m][n][e]), eb = __builtin_amdgcn_exp2f(-1.4426950408889634f * acc[ai][1][m][n][e]);
                            gb[n][e] = __builtin_amdgcn_rcpf(1.f + eb); rt[n][e] = (1.f + eb) * __builtin_amdgcn_rcpf(1.f + ea); }
                    u32x4 w; w.x = cvt_pk_bf16(rt[0][0], rt[0][1]); w.y = cvt_pk_bf16(rt[0][2], rt[0][3]); w.z = cvt_pk_bf16(rt[1][0], rt[1][1]); w.w = cvt_pk_bf16(rt[1][2], rt[1][3]);
                    __builtin_nontemporal_store(w, (u32x4*)rowp);
                    w.x = cvt_pk_bf16(gb[0][0], gb[0][1]); w.y = cvt_pk_bf16(gb[0][2], gb[0][3]); w.z = cvt_pk_bf16(gb[1][0], gb[1][1]); w.w = cvt_pk_bf16(gb[1][2], gb[1][3]);
                    __builtin_nontemporal_store(w, (u32x4*)(rowp + 2048)); }
            return;
        }
#pragma unroll
        for (int ai = 0; ai < 2; ++ai)
#pragma unroll
            for (int m = 0; m < 4; ++m) { bf16_t* rowp = base + (size_t)(row0 + ai * HALF + m * 16) * ld + col0;
#pragma unroll
                for (int bj = 0; bj < 2; ++bj) { if (col0 + bj * HALF < maxcol) { f32x4 v0 = acc[ai][bj][m][0], v1 = acc[ai][bj][m][1];
                    if (sig) {
#pragma unroll
                        for (int e = 0; e < 4; ++e) { v0[e] = __builtin_amdgcn_rcpf(1.f + __builtin_amdgcn_exp2f(-1.4426950408889634f * v0[e])); v1[e] = __builtin_amdgcn_rcpf(1.f + __builtin_amdgcn_exp2f(-1.4426950408889634f * v1[e])); } }
                    u32x4 w; w.x = cvt_pk_bf16(v0[0], v0[1]); w.y = cvt_pk_bf16(v0[2], v0[3]); w.z = cvt_pk_bf16(v1[0], v1[1]); w.w = cvt_pk_bf16(v1[2], v1[3]);
                    if (sig) __builtin_nontemporal_store(w, (u32x4*)(rowp + bj * HALF)); else *(u32x4*)(rowp + bj * HALF) = w; } } }
    }
};
struct EpiKV {
    static constexpr bool PERM = true, AFTER_DRAIN = false, HAS_MID = false;
    bf16_t *ka, *va;
    __device__ __forceinline__ void operator()(const f32x4 (&acc)[2][2][4][2], const Unit& u, int wr, int wc, int fr, int fq) const {
        const int row0 = u.pm * BM + wr * 64 + fr, col0 = u.pn * 128 + wc * 32 + 8 * fq;
#pragma unroll
        for (int ai = 0; ai < 2; ++ai)
#pragma unroll
            for (int m = 0; m < 4; ++m) { const size_t off = (size_t)(row0 + ai * HALF + m * 16) * 1024 + col0;
#pragma unroll
                for (int bj = 0; bj < 2; ++bj) { const f32x4 v0 = acc[ai][bj][m][0], v1 = acc[ai][bj][m][1];
                    u32x4 w; w.x = cvt_pk_bf16(v0[0], v0[1]); w.y = cvt_pk_bf16(v0[2], v0[3]); w.z = cvt_pk_bf16(v1[0], v1[1]); w.w = cvt_pk_bf16(v1[2], v1[3]);
                    *(u32x4*)((bj ? va : ka) + off) = w; } }
    }
};
template <int PASS> struct EpiBr {
    static constexpr bool PERM = true, AFTER_DRAIN = false, HAS_MID = false;
    const bf16_t* gates; bf16_t* O;
    __device__ __forceinline__ void operator()(const f32x4 (&acc)[2][2][4][2], const Unit& u, int wr, int wc, int fr, int fq) const {
        const int row0 = u.pm * BM + wr * 64 + fr, col0 = u.pn * BM + wc * 32 + 8 * fq;
#pragma unroll
        for (int ai = 0; ai < 2; ++ai)
#pragma unroll
            for (int m = 0; m < 4; ++m) { const size_t r = (size_t)(row0 + ai * HALF + m * 16);
#pragma unroll
                for (int bj = 0; bj < 2; ++bj) { const u32x4 b = *(const u32x4*)(gates + r * 4096 + PASS * 2048 + col0 + bj * HALF);
                    f32x4 v0 = acc[ai][bj][m][0], v1 = acc[ai][bj][m][1];
                    v0[0] *= bflo(b[0]); v0[1] *= bfhi(b[0]); v0[2] *= bflo(b[1]); v0[3] *= bfhi(b[1]); v1[0] *= bflo(b[2]); v1[1] *= bfhi(b[2]); v1[2] *= bflo(b[3]); v1[3] *= bfhi(b[3]);
                    if (PASS == 1) { const u32x4 t = *(const u32x4*)(O + r * 2048 + col0 + bj * HALF);
                        v0[0] += bflo(t[0]); v0[1] += bfhi(t[0]); v0[2] += bflo(t[1]); v0[3] += bfhi(t[1]); v1[0] += bflo(t[2]); v1[1] += bfhi(t[2]); v1[2] += bflo(t[3]); v1[3] += bfhi(t[3]); }
                    u32x4 w; w.x = cvt_pk_bf16(v0[0], v0[1]); w.y = cvt_pk_bf16(v0[2], v0[3]); w.z = cvt_pk_bf16(v1[0], v1[1]); w.w = cvt_pk_bf16(v1[2], v1[3]);
                    *(u32x4*)(O + r * 2048 + col0 + bj * HALF) = w; }
                asm volatile("" ::: "memory"); }
    }
};
template <int CTRL> __device__ __forceinline__ float dppf(float old, float src) { return __int_as_float(__builtin_amdgcn_update_dpp(__float_as_int(old), __float_as_int(src), CTRL, 0xf, 0xf, false)); }
template <int CTRL> __device__ __forceinline__ f32x4 dpp4(f32x4 old, f32x4 src) { f32x4 r; r[0] = dppf<CTRL>(old[0], src[0]); r[1] = dppf<CTRL>(old[1], src[1]); r[2] = dppf<CTRL>(old[2], src[2]); r[3] = dppf<CTRL>(old[3], src[3]); return r; }
__device__ __forceinline__ f32x4 silu4(f32x4 x) { f32x4 r;
#pragma unroll
    for (int e = 0; e < 4; ++e) r[e] = x[e] * __builtin_amdgcn_rcpf(1.f + __builtin_amdgcn_exp2f(-1.4426950408889634f * x[e]));
    return r; }
struct EpiUpConv {
    static constexpr bool PERM = true, AFTER_DRAIN = false, HAS_MID = false;
    bf16_t* H; const float* cw; const float* cb; float* PART; float* RAWB; PG8_LAS float* EX;
    __device__ __forceinline__ void operator()(const f32x4 (&acc)[2][2][4][2], const Unit& u, int wr, int wc, int fr, int fq) const {
        const int cl0 = wc * 32 + 8 * fq;
        if (fr == 0) {
#pragma unroll
            for (int ai = 0; ai < 2; ++ai)
#pragma unroll
                for (int bj = 0; bj < 2; ++bj)
#pragma unroll
                    for (int n = 0; n < 2; ++n) *(PG8_LAS f32x4*)(EX + ((2 * ai + wr) * 2 + 0) * 256 + 128 * bj + cl0 + 4 * n) = acc[ai][bj][0][n];
        }
        if (fr == 15) {
#pragma unroll
            for (int ai = 0; ai < 2; ++ai)
#pragma unroll
                for (int bj = 0; bj < 2; ++bj)
#pragma unroll
                    for (int n = 0; n < 2; ++n) *(PG8_LAS f32x4*)(EX + ((2 * ai + wr) * 2 + 1) * 256 + 128 * bj + cl0 + 4 * n) = acc[ai][bj][3][n];
        }
        asm volatile("s_waitcnt lgkmcnt(0)" ::: "memory"); __builtin_amdgcn_s_barrier(); asm volatile("" ::: "memory");
        typedef unsigned u32x2 __attribute__((ext_vector_type(2)));
        u32x2 pk0[2][4];
        const f32x4 z4 = (f32x4){0.f, 0.f, 0.f, 0.f};
#pragma unroll
        for (int n = 0; n < 2; ++n) {
            const int ch = u.pn * 128 + cl0 + 4 * n;
            const f32x4 w0a = *(const f32x4*)(cw + ch), w1a = *(const f32x4*)(cw + 11264 + ch), w2a = *(const f32x4*)(cw + 2 * 11264 + ch);
            const f32x4 w0b = *(const f32x4*)(cw + 5632 + ch), w1b = *(const f32x4*)(cw + 11264 + 5632 + ch), w2b = *(const f32x4*)(cw + 2 * 11264 + 5632 + ch);
            const f32x4 ba = *(const f32x4*)(cb + ch), bb = *(const f32x4*)(cb + 5632 + ch);
#pragma unroll
            for (int ai = 0; ai < 2; ++ai) {
                const int q = 2 * ai + wr;
                f32x4 haf = z4, hbf = z4, hal = z4, hbl = z4;
                if (q > 0) { haf = *(const PG8_LAS f32x4*)(EX + ((q - 1) * 2 + 1) * 256 + cl0 + 4 * n); hbf = *(const PG8_LAS f32x4*)(EX + ((q - 1) * 2 + 1) * 256 + 128 + cl0 + 4 * n); }
                if (q < 3) { hal = *(const PG8_LAS f32x4*)(EX + ((q + 1) * 2) * 256 + cl0 + 4 * n); hbl = *(const PG8_LAS f32x4*)(EX + ((q + 1) * 2) * 256 + 128 + cl0 + 4 * n); }
#pragma unroll
                for (int m = 0; m < 4; ++m) {
                    const f32x4 va = acc[ai][0][m][n], vb = acc[ai][1][m][n];
                    f32x4 xa, xb, ya, yb;
                    if (m == 0) { xa = haf; xb = hbf; } else { xa = dpp4<0x121>(va, acc[ai][0][m - 1][n]); xb = dpp4<0x121>(vb, acc[ai][1][m - 1][n]); }
                    if (m == 3) { ya = hal; yb = hbl; } else { ya = dpp4<0x12F>(va, acc[ai][0][m + 1][n]); yb = dpp4<0x12F>(vb, acc[ai][1][m + 1][n]); }
                    const f32x4 pa = dpp4<0x111>(xa, va), pb = dpp4<0x111>(xb, vb);
                    const f32x4 na = dpp4<0x101>(ya, va), nb = dpp4<0x101>(yb, vb);
                    const f32x4 ca = ba + w0a * pa + w1a * va + w2a * na, cbv = bb + w0b * pb + w1b * vb + w2b * nb;
                    if (q == 0 && m == 0) { if (fr == 0) { const size_t o = (size_t)(u.pm * 2 + 0) * 11264 + u.pn * 256 + cl0 + 4 * n;
                        *(f32x4*)(PART + o) = ca; *(f32x4*)(PART + o + 128) = cbv; *(f32x4*)(RAWB + o) = va; *(f32x4*)(RAWB + o + 128) = vb; } }
                    if (q == 3 && m == 3) { if (fr == 15) { const size_t o = (size_t)(u.pm * 2 + 1) * 11264 + u.pn * 256 + cl0 + 4 * n;
                        *(f32x4*)(PART + o) = ca; *(f32x4*)(PART + o + 128) = cbv; *(f32x4*)(RAWB + o) = va; *(f32x4*)(RAWB + o + 128) = vb; } }
                    const f32x4 h = silu4(ca) * cbv;
                    u32x2 pk; pk.x = cvt_pk_bf16(h[0], h[1]); pk.y = cvt_pk_bf16(h[2], h[3]);
                    if (n == 0) pk0[ai][m] = pk;
                    else { u32x4 w; w.x = pk0[ai][m].x; w.y = pk0[ai][m].y; w.z = pk.x; w.w = pk.y;
                        __builtin_nontemporal_store(w, (u32x4*)(H + (size_t)(u.pm * BM + ai * HALF + wr * 64 + m * 16 + fr) * 5632 + u.pn * 128 + cl0)); }
                }
            }
        }
    }
};
struct EpiBrH {
    static constexpr bool PERM = true, AFTER_DRAIN = false, HAS_MID = true;
    const bf16_t* gates; bf16_t* O;
    __device__ __forceinline__ void mid(f32x4 (&acc)[2][2][4][2], const Unit& u, int wr, int wc, int fr, int fq) const {
        int row0 = u.pm * BM + wr * 64 + fr, col0 = u.pn * BM + wc * 32 + 8 * fq;
        asm volatile("" : "+v"(row0), "+v"(col0) :: "memory");
#pragma unroll
        for (int ai = 0; ai < 2; ++ai)
#pragma unroll
            for (int m = 0; m < 4; ++m) {
                int roff = row0 + ai * HALF + m * 16; asm volatile("" : "+v"(roff) :: "memory"); const bf16_t* gp = gates + (size_t)roff * 4096 + col0;
#pragma unroll
                for (int bj = 0; bj < 2; ++bj) { const u32x4 a = __builtin_nontemporal_load((const u32x4*)(gp + bj * HALF));
                    f32x4 r0, r1;
                    r0[0] = bflo(a[0]); r0[1] = bfhi(a[0]); r0[2] = bflo(a[1]); r0[3] = bfhi(a[1]); r1[0] = bflo(a[2]); r1[1] = bfhi(a[2]); r1[2] = bflo(a[3]); r1[3] = bfhi(a[3]);
                    acc[ai][bj][m][0] = acc[ai][bj][m][0] * r0; acc[ai][bj][m][1] = acc[ai][bj][m][1] * r1; }
                asm volatile("" : "+v"(acc[ai][0][m][0]), "+v"(acc[ai][0][m][1]), "+v"(acc[ai][1][m][0]), "+v"(acc[ai][1][m][1]));
                __builtin_amdgcn_sched_barrier(0);
            }
    }
    __device__ __forceinline__ void operator()(const f32x4 (&acc)[2][2][4][2], const Unit& u, int wr, int wc, int fr, int fq) const {
        const int row0 = u.pm * BM + wr * 64 + fr, col0 = u.pn * BM + wc * 32 + 8 * fq;
#pragma unroll
        for (int ai = 0; ai < 2; ++ai)
#pragma unroll
            for (int m = 0; m < 4; ++m) { const size_t r = (size_t)(row0 + ai * HALF + m * 16);
#pragma unroll
                for (int bj = 0; bj < 2; ++bj) { const u32x4 b = *(const u32x4*)(gates + r * 4096 + 2048 + col0 + bj * HALF);
                    const f32x4 v0 = acc[ai][bj][m][0], v1 = acc[ai][bj][m][1];
                    u32x4 w; w.x = cvt_pk_bf16(v0[0] * bflo(b[0]), v0[1] * bfhi(b[0])); w.y = cvt_pk_bf16(v0[2] * bflo(b[1]), v0[3] * bfhi(b[1]));
                    w.z = cvt_pk_bf16(v1[0] * bflo(b[2]), v1[1] * bfhi(b[2])); w.w = cvt_pk_bf16(v1[2] * bflo(b[3]), v1[3] * bfhi(b[3]));
                    *(u32x4*)(O + r * 2048 + col0 + bj * HALF) = w; }
                asm volatile("" ::: "memory"); }
    }
};
struct EpiRes {
    static constexpr bool PERM = false, AFTER_DRAIN = false, HAS_MID = false;
    const float* base; float* out; const float* g;
    __device__ __forceinline__ void operator()(const f32x4 (&acc)[2][2][4][2], const Unit& u, int wr, int wc, int fr, int fq) const {
        const int row0 = u.pm * BM + wr * 64 + fr, col0 = u.pn * BM + wc * 32 + 4 * fq;
        const float* gb = g + (size_t)(u.pm >> 3) * 12288 + col0;
        f32x4 gv[2][2];
#pragma unroll
        for (int bj = 0; bj < 2; ++bj)
#pragma unroll
            for (int n = 0; n < 2; ++n) gv[bj][n] = *(const f32x4*)(gb + bj * HALF + n * 16);
#pragma unroll
        for (int ai = 0; ai < 2; ++ai)
#pragma unroll
            for (int m = 0; m < 4; ++m) { const size_t off = (size_t)(row0 + ai * HALF + m * 16) * 2048 + col0;
#pragma unroll
                for (int bj = 0; bj < 2; ++bj)
#pragma unroll
                    for (int n = 0; n < 2; ++n) { const f32x4 bs = *(const f32x4*)(base + off + bj * HALF + n * 16);
                        *(f32x4*)(out + off + bj * HALF + n * 16) = bs + gv[bj][n] * acc[ai][bj][m][n]; } }
    }
};
template <typename TB> struct EpiResB {
    static constexpr bool PERM = true, AFTER_DRAIN = false, HAS_MID = false;
    const TB* base; bf16_t* out; const float* g;
    __device__ __forceinline__ void operator()(const f32x4 (&acc)[2][2][4][2], const Unit& u, int wr, int wc, int fr, int fq) const {
        const int row0 = u.pm * BM + wr * 64 + fr, col0 = u.pn * BM + wc * 32 + 8 * fq;
        const float* gb = g + (size_t)(u.pm >> 3) * 12288 + col0;
        f32x4 gv[2][2];
#pragma unroll
        for (int bj = 0; bj < 2; ++bj)
#pragma unroll
            for (int n = 0; n < 2; ++n) gv[bj][n] = *(const f32x4*)(gb + bj * HALF + n * 4);
#pragma unroll
        for (int ai = 0; ai < 2; ++ai)
#pragma unroll
            for (int m = 0; m < 4; ++m) { const size_t off = (size_t)(row0 + ai * HALF + m * 16) * 2048 + col0;
#pragma unroll
                for (int bj = 0; bj < 2; ++bj) { f32x4 b0, b1;
                    if constexpr (sizeof(TB) == 4) { b0 = __builtin_nontemporal_load((const f32x4*)((const float*)base + off + bj * HALF)); b1 = __builtin_nontemporal_load((const f32x4*)((const float*)base + off + bj * HALF + 4)); }
                    else { const u32x4 t = *(const u32x4*)((const bf16_t*)base + off + bj * HALF);
                        b0[0] = bflo(t[0]); b0[1] = bfhi(t[0]); b0[2] = bflo(t[1]); b0[3] = bfhi(t[1]); b1[0] = bflo(t[2]); b1[1] = bfhi(t[2]); b1[2] = bflo(t[3]); b1[3] = bfhi(t[3]); }
                    const f32x4 v0 = b0 + gv[bj][0] * acc[ai][bj][m][0], v1 = b1 + gv[bj][1] * acc[ai][bj][m][1];
                    u32x4 w; w.x = cvt_pk_bf16(v0[0], v0[1]); w.y = cvt_pk_bf16(v0[2], v0[3]); w.z = cvt_pk_bf16(v1[0], v1[1]); w.w = cvt_pk_bf16(v1[2], v1[3]);
                    *(u32x4*)(out + off + bj * HALF) = w; } }
    }
};
struct ProjOrder {
    StaticOrder so; int G, c;
    __device__ void init(int G_, int c_) { so.init(16384, 7168, G_, c_); G = G_; c = c_; }
    __device__ bool next(int i, Unit& u) const {
        const long L = (long)i * G + c;
        if (L < 1792) { Unit t; so.next(i, t); u.pm = (t.pm >> 3) * 9 + 1 + (t.pm & 7); u.pn = t.pn; return true; }
        if (L < 1832) { const int q = (int)(L - 1792); u.pm = (q / 5) * 9; u.pn = q % 5; return true; }
        return false;
    }
    __device__ __forceinline__ void a_ready(const Unit&) const {}
    __device__ __forceinline__ void done(const Unit&) const {}
};
struct ListOrder {
    int first, n, rows, rowbase;
    __device__ bool next(int i, Unit& u) const { if (i >= n) return false; const int q = first + i; u.pm = rowbase + q % rows; u.pn = q / rows; return true; }
    __device__ __forceinline__ void a_ready(const Unit&) const {}
    __device__ __forceinline__ void done(const Unit&) const {}
};
}
namespace pg8 {
template <class Epi, class Sched, bool ALIGN_EPI = false, bool SP2 = false>
__device__ __forceinline__ void gemm_phase(PG8_LAS unsigned char* lds, const Gemm g, const Sched& S, const Epi& E) {
    int tid = threadIdx.x; asm volatile("" : "+v"(tid));
    const int wid = __builtin_amdgcn_readfirstlane(tid >> 6), lane = tid & 63, wr = wid >> 2, wc = wid & 3, fr = lane & 15, fq = lane >> 4;
    const int K = g.K, nt = K / BK;
    unsigned voffA[2], voffB[2];
#pragma unroll
    for (int i = 0; i < 2; ++i) { int R, C; stage_rc(tid * 16 + i * 8192, R, C); const int Rb = Epi::PERM ? ((R & ~31) + perm32(R & 31)) : R;
        voffA[i] = (unsigned)(R * K + C) * 2u; voffB[i] = (unsigned)(Rb * K + C) * 2u; }
    const size_t kstep = (size_t)(BK * 2);
    const size_t hstep = (size_t)HALF * K * 2;
    const size_t tstep = 2 * hstep;
    const unsigned ldsw = (unsigned)wid * 1024u;
    const int aoff = lds_byte(wr * 64 + fr, fq * 8), boff = lds_byte(wc * 32 + fr, fq * 8);
#define PG8_SA(b, h) (((b) * 2 + (h)) * HTB)
#define PG8_SB(b, h) ((4 + (b) * 2 + (h)) * HTB)
#define PG8_STAGE(bufoff, gbase, voff) do { _Pragma("unroll") for (int _i = 0; _i < 2; ++_i) \
        __builtin_amdgcn_global_load_lds((const unsigned*)((const char*)(gbase) + (voff)[_i]), (PG8_LAS unsigned*)(lds + (bufoff) + ldsw + _i * 8192), 16, 0, 0); } while (0)
#define PG8_LDA(dst, b, h) do { _Pragma("unroll") for (int m = 0; m < 4; ++m) _Pragma("unroll") for (int k = 0; k < 2; ++k) dst[m][k] = *(const PG8_LAS bf16x8*)(lds + PG8_SA(b, h) + aoff + m * 2048 + k * 1024); } while (0)
#define PG8_LDB(dst, b, h) do { _Pragma("unroll") for (int n = 0; n < 2; ++n) _Pragma("unroll") for (int k = 0; k < 2; ++k) dst[n][k] = *(const PG8_LAS bf16x8*)(lds + PG8_SB(b, h) + boff + n * 2048 + k * 1024); } while (0)
#define PG8_MMA(ai, bj, At, Bt) do { __builtin_amdgcn_s_setprio(1); _Pragma("unroll") for (int m = 0; m < 4; ++m) _Pragma("unroll") for (int n = 0; n < 2; ++n) _Pragma("unroll") for (int k = 0; k < 2; ++k) \
        acc[ai][bj][m][n] = __builtin_amdgcn_mfma_f32_16x16x32_bf16(Bt[n][k], At[m][k], acc[ai][bj][m][n], 0, 0, 0); __builtin_amdgcn_s_setprio(0); } while (0)
#define PG8_WAIT_V(n) asm volatile("s_waitcnt vmcnt(" #n ")" ::: "memory")
#define PG8_WAIT_L(n) asm volatile("s_waitcnt lgkmcnt(" #n ")" ::: "memory")
#define PG8_BAR __builtin_amdgcn_s_barrier()
#define PG8_SCHED __builtin_amdgcn_sched_barrier(0)
    Unit cur, nxt; int ui = 0;
    if (!S.next(0, cur)) return;
    f32x4 acc[2][2][4][2];
#pragma unroll
    for (int a = 0; a < 2; ++a)
#pragma unroll
        for (int b = 0; b < 2; ++b)
#pragma unroll
            for (int m = 0; m < 4; ++m)
#pragma unroll
                for (int n = 0; n < 2; ++n) acc[a][b][m][n] = (f32x4){0.f, 0.f, 0.f, 0.f};
    bf16x8 At[4][2], B0[2][2], B1[2][2];
    const char* cA = (const char*)g.A + (size_t)cur.pm * tstep; const char* cB = (const char*)g.Bt + (size_t)cur.pn * tstep;
    S.a_ready(cur);
    if constexpr (SP2) {
        PG8_STAGE(PG8_SB(0, 0), cB, voffB); PG8_STAGE(PG8_SB(0, 1), cB + hstep, voffB); PG8_STAGE(PG8_SA(0, 0), cA, voffA); PG8_STAGE(PG8_SA(0, 1), cA + hstep, voffA);
        if (wr == 1) PG8_BAR;
        PG8_WAIT_V(2); PG8_BAR;
        PG8_STAGE(PG8_SB(1, 0), cB + kstep, voffB); PG8_STAGE(PG8_SA(1, 0), cA + kstep, voffA); PG8_STAGE(PG8_SB(1, 1), cB + hstep + kstep, voffB);
        PG8_WAIT_V(6); PG8_BAR;
    } else {
        PG8_STAGE(PG8_SB(0, 0), cB, voffB); PG8_STAGE(PG8_SA(0, 0), cA, voffA); PG8_STAGE(PG8_SB(0, 1), cB + hstep, voffB); PG8_STAGE(PG8_SA(0, 1), cA + hstep, voffA);
        if (wr == 1) PG8_BAR;
        PG8_WAIT_V(4); PG8_BAR;
        PG8_STAGE(PG8_SB(1, 0), cB + kstep, voffB); PG8_STAGE(PG8_SA(1, 0), cA + kstep, voffA); PG8_STAGE(PG8_SB(1, 1), cB + hstep + kstep, voffB);
        PG8_WAIT_V(6); PG8_BAR;
    }
    for (;;) {
        const bool has_next = S.next(ui + 1, nxt);
        const char* nA = has_next ? (const char*)g.A + (size_t)nxt.pm * tstep : cA; const char* nB = has_next ? (const char*)g.Bt + (size_t)nxt.pn * tstep : cB;
        constexpr int NSEG = Epi::HAS_MID ? 2 : 1; const int tseg = nt / NSEG;
#pragma unroll
        for (int seg = 0; seg < NSEG; ++seg) {
        if constexpr (Epi::HAS_MID) { if (seg == 1) E.mid(acc, cur, wr, wc, fr, fq); }
        for (int t = seg * tseg; t < (seg + 1) * tseg; t += 2) {
            const bool last = (t == nt - 2);
            const char* a1 = cA + (size_t)(t + 1) * kstep;
            const char* a2 = last ? nA : cA + (size_t)(t + 2) * kstep; const char* b2 = last ? nB : cB + (size_t)(t + 2) * kstep;
            const char* a3 = a2 + kstep; const char* b3 = b2 + kstep;
            if (last && has_next) S.a_ready(nxt);
            if constexpr (SP2) {
            PG8_LDB(B0, 0, 0); PG8_LDB(B1, 0, 1); PG8_SCHED; PG8_LDA(At, 0, 0); PG8_STAGE(PG8_SA(1, 1), a1 + hstep, voffA);
            PG8_WAIT_V(8); PG8_WAIT_L(0); PG8_BAR; PG8_MMA(0, 0, At, B0); PG8_MMA(0, 1, At, B1); PG8_BAR; PG8_SCHED;
            PG8_LDA(At, 0, 1); PG8_STAGE(PG8_SB(0, 0), b2, voffB); PG8_STAGE(PG8_SB(0, 1), b2 + hstep, voffB); PG8_STAGE(PG8_SA(0, 0), a2, voffA);
            PG8_WAIT_V(8); PG8_WAIT_L(0); PG8_BAR; PG8_MMA(1, 0, At, B0); PG8_MMA(1, 1, At, B1); PG8_BAR; PG8_SCHED;
            PG8_LDB(B0, 1, 0); PG8_LDB(B1, 1, 1); PG8_SCHED; PG8_LDA(At, 1, 0); PG8_STAGE(PG8_SA(0, 1), a2 + hstep, voffA);
            PG8_WAIT_V(8); PG8_WAIT_L(0); PG8_BAR; PG8_MMA(0, 0, At, B0); PG8_MMA(0, 1, At, B1); PG8_BAR; PG8_SCHED;
            PG8_LDA(At, 1, 1); PG8_STAGE(PG8_SB(1, 0), b3, voffB); PG8_STAGE(PG8_SB(1, 1), b3 + hstep, voffB); PG8_STAGE(PG8_SA(1, 0), a3, voffA);
            PG8_WAIT_V(8); PG8_WAIT_L(0); PG8_BAR; PG8_MMA(1, 0, At, B0); PG8_MMA(1, 1, At, B1); PG8_BAR; PG8_SCHED;
            } else {
            PG8_LDB(B0, 0, 0); PG8_SCHED; PG8_LDA(At, 0, 0); PG8_STAGE(PG8_SA(1, 1), a1 + hstep, voffA);
            PG8_WAIT_L(8); PG8_BAR; PG8_WAIT_L(0); PG8_MMA(0, 0, At, B0); PG8_BAR; PG8_SCHED;
            PG8_LDB(B1, 0, 1); PG8_STAGE(PG8_SB(0, 0), b2, voffB);
            PG8_BAR; PG8_WAIT_L(0); PG8_MMA(0, 1, At, B1); PG8_BAR;
            PG8_LDA(At, 0, 1); PG8_STAGE(PG8_SA(0, 0), a2, voffA);
            PG8_BAR; PG8_WAIT_L(0); PG8_MMA(1, 0, At, B0); PG8_BAR; PG8_SCHED;
            PG8_STAGE(PG8_SB(0, 1), b2 + hstep, voffB);
            PG8_WAIT_V(6); PG8_BAR; PG8_MMA(1, 1, At, B1); PG8_BAR;
            PG8_LDB(B0, 1, 0); PG8_SCHED; PG8_LDA(At, 1, 0); PG8_STAGE(PG8_SA(0, 1), a2 + hstep, voffA);
            PG8_WAIT_L(8); PG8_BAR; PG8_WAIT_L(0); PG8_MMA(0, 0, At, B0); PG8_BAR; PG8_SCHED;
            PG8_LDB(B1, 1, 1); PG8_STAGE(PG8_SB(1, 0), b3, voffB);
            PG8_BAR; PG8_WAIT_L(0); PG8_MMA(0, 1, At, B1); PG8_BAR;
            PG8_LDA(At, 1, 1); PG8_STAGE(PG8_SA(1, 0), a3, voffA);
            PG8_BAR; PG8_WAIT_L(0); PG8_MMA(1, 0, At, B0); PG8_BAR; PG8_SCHED;
            PG8_STAGE(PG8_SB(1, 1), b3 + hstep, voffB);
            PG8_WAIT_V(6); PG8_BAR; PG8_MMA(1, 1, At, B1); PG8_BAR;
            }
        }
        }
        if constexpr (ALIGN_EPI) { if (wr == 0) PG8_BAR; }
        if constexpr (!Epi::AFTER_DRAIN) { E(acc, cur, wr, wc, fr, fq); S.done(cur); }
        if (!has_next) break;
#pragma unroll
        for (int a = 0; a < 2; ++a)
#pragma unroll
            for (int b = 0; b < 2; ++b)
#pragma unroll
                for (int m = 0; m < 4; ++m)
#pragma unroll
                    for (int n = 0; n < 2; ++n) acc[a][b][m][n] = (f32x4){0.f, 0.f, 0.f, 0.f};
        cur = nxt; cA = nA; cB = nB; ++ui;
        if constexpr (ALIGN_EPI) { if (wr == 1) PG8_BAR; }
    }
    PG8_WAIT_V(0);
    if constexpr (!ALIGN_EPI) { if (wr == 0) PG8_BAR; }
    PG8_BAR;
    if constexpr (Epi::AFTER_DRAIN) { E.fused(acc, cur, wr, wc, fr, fq, lds, wid, lane); S.done(cur); }
#undef PG8_SA
#undef PG8_SB
#undef PG8_STAGE
#undef PG8_LDA
#undef PG8_LDB
#undef PG8_MMA
#undef PG8_WAIT_V
#undef PG8_WAIT_L
#undef PG8_BAR
#undef PG8_SCHED
}
}

namespace att {
using bf16_t = unsigned short;
using bf16x8 = __attribute__((ext_vector_type(8))) short;
using s16x4  = __attribute__((ext_vector_type(4))) short;
using f32x16 = __attribute__((ext_vector_type(16))) float;
using u32x4  = __attribute__((ext_vector_type(4))) unsigned;
constexpr int D = 128, NW = 8, QBLK = 32, KVBLK = 64;
#ifndef NQL
#define NQL 5
#endif
#ifndef NQL0
#define NQL0 0
#endif
#ifndef MLA_SD
#define MLA_SD 1
#endif
constexpr float THR = 8.f;
constexpr int SHM_V = KVBLK * D * 2, SHM_K = KVBLK * D * 2, SHM_KR = KVBLK * 64 * 2;
constexpr int OFF_V = 0, OFF_K = 2 * SHM_V, OFF_WS = OFF_K + 2 * SHM_K, OFF_KR = OFF_WS + NW * 64 * 4, OFF_QR = OFF_KR + 2 * SHM_KR, QRW = (4 + NQL) * 1024, LDS_BYTES = OFF_QR + NW * QRW;
#define KSWZ(row, colB) ((row) * 256 + ((colB) ^ (((row) & 15) << 4)))
#define KRSWZ(row, colB) ((row) * 128 + ((colB) ^ ((((row) >> 1) & 7) << 4)))
#define SBAR() __builtin_amdgcn_sched_barrier(0)
__device__ __forceinline__ int crow(int r, int hi) { return (r & 3) + 8 * (r >> 2) + 4 * hi; }
__device__ __forceinline__ unsigned cvtpk(float lo, float hi) { unsigned r; asm volatile("v_cvt_pk_bf16_f32 %0, %1, %2" : "=v"(r) : "v"(lo), "v"(hi)); return r; }
__device__ __forceinline__ void partialSM(f32x16& p0, f32x16& p1, float& m_reg, float& mn, float& alpha, const float SCALE) {
  const float C = SCALE * 1.4426950408889634f;
  float pmax = p0[0];
#pragma unroll
  for (int r = 1; r < 16; ++r) pmax = fmaxf(pmax, p0[r]);
#pragma unroll
  for (int r = 0; r < 16; ++r) pmax = fmaxf(pmax, p1[r]);
  { auto rr = __builtin_amdgcn_permlane32_swap(__float_as_uint(pmax), __float_as_uint(pmax), false, false);
    pmax = fmaxf(__uint_as_float(rr[0]), __uint_as_float(rr[1])); }
  if (__builtin_expect(__all(pmax - m_reg <= THR / SCALE), 1)) { mn = m_reg; alpha = 1.f; }
  else { mn = fmaxf(m_reg, pmax); alpha = __builtin_amdgcn_exp2f((m_reg - mn) * C); m_reg = mn; }
  float mnC = -mn * C;
#pragma unroll
  for (int r = 0; r < 16; ++r) p0[r] = fmaf(p0[r], C, mnC);
#pragma unroll
  for (int r = 0; r < 16; ++r) p1[r] = fmaf(p1[r], C, mnC);
#pragma unroll
  for (int r = 0; r < 16; ++r) p0[r] = __builtin_amdgcn_exp2f(p0[r]);
}
__device__ __forceinline__ void finishSM(f32x16& p0, f32x16& p1, float alpha, float& l_reg, bf16x8& pa0, bf16x8& pa1, bf16x8& pa2, bf16x8& pa3) {
#pragma unroll
  for (int r = 0; r < 16; ++r) p1[r] = __builtin_amdgcn_exp2f(p1[r]);
  float ps, ps1 = 0.f, ps2 = 0.f, ps3 = 0.f; ps = 0.f;
#pragma unroll
  for (int r = 0; r < 16; r += 4) { ps += p0[r]; ps1 += p0[r + 1]; ps2 += p0[r + 2]; ps3 += p0[r + 3]; }
#pragma unroll
  for (int r = 0; r < 16; r += 4) { ps += p1[r]; ps1 += p1[r + 1]; ps2 += p1[r + 2]; ps3 += p1[r + 3]; }
  ps = (ps + ps1) + (ps2 + ps3);
  { auto rr = __builtin_amdgcn_permlane32_swap(__float_as_uint(ps), __float_as_uint(ps), false, false);
    ps = __uint_as_float(rr[0]) + __uint_as_float(rr[1]); }
  l_reg = l_reg * alpha + ps;
#define PK4(P, BASE, OUT) do { unsigned a0 = cvtpk(P[BASE + 0], P[BASE + 1]), a1 = cvtpk(P[BASE + 2], P[BASE + 3]);   \
    unsigned b0 = cvtpk(P[BASE + 4], P[BASE + 5]), b1 = cvtpk(P[BASE + 6], P[BASE + 7]);                              \
    auto r0 = __builtin_amdgcn_permlane32_swap(a0, b0, false, false); auto r1 = __builtin_amdgcn_permlane32_swap(a1, b1, false, false); \
    u32x4 w = {r0[0], r1[0], r0[1], r1[1]}; OUT = *reinterpret_cast<bf16x8*>(&w); } while (0)
  PK4(p0, 0, pa0); PK4(p0, 8, pa1); PK4(p1, 0, pa2); PK4(p1, 8, pa3);
#undef PK4
}
template <int DKR, int NQ>
__device__ __forceinline__ void qkt(f32x16& p0, f32x16& p1, const char* Ks, const char* Krs, const char* Qrs, const bf16x8* qr, int r32, int hi, int lane) {
  p0 = f32x16{}; p1 = f32x16{};
#pragma unroll
  for (int d0 = 0; d0 < 8; ++d0) { int cb = (d0 * 16 + hi * 8) * 2;
    bf16x8 b0 = *reinterpret_cast<const bf16x8*>(Ks + KSWZ(r32, cb));
    bf16x8 b1 = *reinterpret_cast<const bf16x8*>(Ks + KSWZ(32 + r32, cb));
    bf16x8 qf;
    if (d0 >= 8 - NQ) qf = *reinterpret_cast<const bf16x8*>(Qrs + (d0 - (8 - NQ) + 4) * 1024 + lane * 16); else qf = qr[d0];
    p0 = __builtin_amdgcn_mfma_f32_32x32x16_bf16(b0, qf, p0, 0, 0, 0);
    p1 = __builtin_amdgcn_mfma_f32_32x32x16_bf16(b1, qf, p1, 0, 0, 0); }
  if constexpr (DKR > 0) {
    SBAR();
#pragma unroll
    for (int d0 = 0; d0 < DKR / 16; ++d0) { int cb = (d0 * 16 + hi * 8) * 2;
      bf16x8 b0 = *reinterpret_cast<const bf16x8*>(Krs + KRSWZ(r32, cb));
      bf16x8 b1 = *reinterpret_cast<const bf16x8*>(Krs + KRSWZ(32 + r32, cb));
      bf16x8 qf = *reinterpret_cast<const bf16x8*>(Qrs + d0 * 1024 + lane * 16);
      p0 = __builtin_amdgcn_mfma_f32_32x32x16_bf16(b0, qf, p0, 0, 0, 0);
      p1 = __builtin_amdgcn_mfma_f32_32x32x16_bf16(b1, qf, p1, 0, 0, 0); }
  }
}
__device__ __forceinline__ int v_st(int k, int c) { const int kk = (k & ~0xC) | ((k & 4) << 1) | ((k & 8) >> 1); return ((kk >> 3) * 4 + (c >> 5)) * 512 + ((kk & 7) * 32 + (c & 31)) * 2; }
__device__ __forceinline__ int v_rd_base(int lane) { return ((lane & 3) << 3) | (((lane >> 2) & 3) << 6) | (((lane >> 4) & 1) << 5) | (((lane >> 5) & 1) << 8); }
constexpr int v_rd_off(int d0, int ks, int half) { return d0 * 512 + ks * 4096 + half * 2048; }
template <int OFF> __device__ __forceinline__ s16x4 tr_read(int vb) {
  s16x4 r; asm volatile("ds_read_b64_tr_b16 %0, %1 offset:%2" : "=&v"(r) : "v"(vb), "i"(OFF) : "memory"); return r;
}
template <int D0> __device__ __forceinline__ void pv_one(f32x16& od, int vb, bf16x8 pa0, bf16x8 pa1, bf16x8 pa2, bf16x8 pa3) {
  const s16x4 l0 = tr_read<v_rd_off(D0, 0, 0)>(vb), h0 = tr_read<v_rd_off(D0, 0, 1)>(vb), l1 = tr_read<v_rd_off(D0, 1, 0)>(vb), h1 = tr_read<v_rd_off(D0, 1, 1)>(vb);
  const s16x4 l2 = tr_read<v_rd_off(D0, 2, 0)>(vb), h2 = tr_read<v_rd_off(D0, 2, 1)>(vb), l3 = tr_read<v_rd_off(D0, 3, 0)>(vb), h3 = tr_read<v_rd_off(D0, 3, 1)>(vb);
  asm volatile("s_waitcnt lgkmcnt(0)" ::: "memory"); SBAR();
#define PK(L, H) (bf16x8){L[0], L[1], L[2], L[3], H[0], H[1], H[2], H[3]}
  od = __builtin_amdgcn_mfma_f32_32x32x16_bf16(pa0, PK(l0, h0), od, 0, 0, 0);
  od = __builtin_amdgcn_mfma_f32_32x32x16_bf16(pa1, PK(l1, h1), od, 0, 0, 0);
  od = __builtin_amdgcn_mfma_f32_32x32x16_bf16(pa2, PK(l2, h2), od, 0, 0, 0);
  od = __builtin_amdgcn_mfma_f32_32x32x16_bf16(pa3, PK(l3, h3), od, 0, 0, 0);
#undef PK
}
__device__ __forceinline__ void pv_d0(f32x16* o, int vb, bf16x8 pa0, bf16x8 pa1, bf16x8 pa2, bf16x8 pa3) {
  pv_one<0>(o[0], vb, pa0, pa1, pa2, pa3); pv_one<1>(o[1], vb, pa0, pa1, pa2, pa3); pv_one<2>(o[2], vb, pa0, pa1, pa2, pa3); pv_one<3>(o[3], vb, pa0, pa1, pa2, pa3);
}
__device__ __forceinline__ void pv_sm(f32x16* o, int vb, bf16x8 pa0, bf16x8 pa1, bf16x8 pa2, bf16x8 pa3, f32x16& p0, f32x16& p1, float& m_reg, float& mn, float& alpha, const float SCALE) {
  const float C = SCALE * 1.4426950408889634f;
  pv_one<0>(o[0], vb, pa0, pa1, pa2, pa3);
  float ma = fmaxf(fmaxf(p0[0], p0[1]), p0[2]), mb = fmaxf(fmaxf(p0[3], p0[4]), p0[5]), mc = fmaxf(fmaxf(p0[6], p0[7]), p0[8]), md = fmaxf(fmaxf(p0[9], p0[10]), p0[11]);
  ma = fmaxf(fmaxf(ma, p0[12]), p0[13]); mb = fmaxf(fmaxf(mb, p0[14]), p0[15]);
  float pmax = fmaxf(fmaxf(fmaxf(ma, mb), mc), md);
  pv_one<1>(o[1], vb, pa0, pa1, pa2, pa3);
  { float na = fmaxf(fmaxf(p1[0], p1[1]), p1[2]), nb = fmaxf(fmaxf(p1[3], p1[4]), p1[5]), nc = fmaxf(fmaxf(p1[6], p1[7]), p1[8]), nd = fmaxf(fmaxf(p1[9], p1[10]), p1[11]);
    na = fmaxf(fmaxf(na, p1[12]), p1[13]); nb = fmaxf(fmaxf(nb, p1[14]), p1[15]);
    pmax = fmaxf(fmaxf(fmaxf(fmaxf(pmax, na), nb), nc), nd); }
  { auto rr = __builtin_amdgcn_permlane32_swap(__float_as_uint(pmax), __float_as_uint(pmax), false, false);
    pmax = fmaxf(__uint_as_float(rr[0]), __uint_as_float(rr[1])); }
  if (__builtin_expect(__all(pmax - m_reg <= THR / SCALE), 1)) { mn = m_reg; alpha = 1.f; }
  else { mn = fmaxf(m_reg, pmax); alpha = __builtin_amdgcn_exp2f((m_reg - mn) * C); m_reg = mn; }
  const float mnC = -mn * C;
  pv_one<2>(o[2], vb, pa0, pa1, pa2, pa3);
#pragma unroll
  for (int r = 0; r < 16; ++r) p0[r] = fmaf(p0[r], C, mnC);
#pragma unroll
  for (int r = 0; r < 16; ++r) p1[r] = fmaf(p1[r], C, mnC);
  pv_one<3>(o[3], vb, pa0, pa1, pa2, pa3);
#pragma unroll
  for (int r = 0; r < 16; ++r) p0[r] = __builtin_amdgcn_exp2f(p0[r]);
}
template <int DKR, int LDQ, int LDK, int LDV, int LDO>
__device__ __forceinline__ void attn_unit(const bf16_t* __restrict__ Qb, const bf16_t* __restrict__ Kh, const bf16_t* __restrict__ Kr, const bf16_t* __restrict__ Vh,
                                          bf16_t* __restrict__ Ob, int seq, char* lds, int qpos0, const float* __restrict__ rtab64) {
  constexpr float SCALE = DKR ? 0.07216878364870322f : 0.08838834764831845f;
  int tid = threadIdx.x; asm volatile("" : "+v"(tid));
  const int wid = tid >> 6, lane = tid & 63, r32 = lane & 31, hi = lane >> 5;
  char* V_lds = lds + OFF_V; char* K_lds = lds + OFF_K; char* KR_lds = lds + OFF_KR; char* QR_lds = lds + OFF_QR + wid * QRW;
  float* ws = (float*)(lds + OFF_WS) + wid * 64; float* li_l = ws; float* al_l = ws + 32;
  float m_reg = -1e30f, l_reg = 0; f32x16 o[4] = {}; constexpr int NQ = DKR ? NQL : NQL0; bf16x8 qr[8 - NQ];
  const bf16_t* Qw = Qb + (long)(wid * QBLK + r32) * LDQ + hi * 8;
#pragma unroll
  for (int d0 = 0; d0 < 8 - NQ; ++d0) qr[d0] = *reinterpret_cast<const bf16x8*>(Qw + d0 * 16);
#pragma unroll
  for (int d0 = 8 - NQ; d0 < 8; ++d0) *reinterpret_cast<bf16x8*>(QR_lds + (d0 - (8 - NQ) + 4) * 1024 + lane * 16) = *reinterpret_cast<const bf16x8*>(Qw + d0 * 16);
  if constexpr (DKR > 0) {
    bf16x8 qf[4];
#pragma unroll
    for (int d0 = 0; d0 < 4; ++d0) qf[d0] = *reinterpret_cast<const bf16x8*>(Qw + 128 + d0 * 16);
    const int tpos = qpos0 + wid * QBLK + r32;
#pragma unroll
    for (int ax = 0; ax < 2; ++ax) { const int ipos = ax ? (tpos & 63) : (tpos >> 6);
#pragma unroll
      for (int e = 0; e < 8; e += 2) { float o1[2], o2[2];
        const float4 cst = *reinterpret_cast<const float4*>(rtab64 + (ipos * 16 + 8 * hi + e) * 2);
#pragma unroll
        for (int k = 0; k < 2; ++k) { const float cs = k ? cst.z : cst.x, sn = k ? cst.w : cst.y;
          const float x1 = __uint_as_float(((unsigned)(unsigned short)qf[2 * ax][e + k]) << 16), x2 = __uint_as_float(((unsigned)(unsigned short)qf[2 * ax + 1][e + k]) << 16);
          o1[k] = x1 * cs - x2 * sn; o2[k] = x1 * sn + x2 * cs; }
        const unsigned w1 = cvtpk(o1[0], o1[1]), w2 = cvtpk(o2[0], o2[1]);
        qf[2 * ax][e] = (short)(w1 & 0xffffu); qf[2 * ax][e + 1] = (short)(w1 >> 16); qf[2 * ax + 1][e] = (short)(w2 & 0xffffu); qf[2 * ax + 1][e + 1] = (short)(w2 >> 16); } }
#pragma unroll
    for (int d0 = 0; d0 < 4; ++d0) *reinterpret_cast<bf16x8*>(QR_lds + d0 * 1024 + lane * 16) = qf[d0];
  }
  const int sr = tid >> 4, sc = (tid & 15) * 8, vst0 = v_st(sr, sc), vst1 = v_st(32 + sr, sc);
  const int krr = tid >> 3, krc = (tid & 7) * 8;
  const int vb0 = (int)(uintptr_t)V_lds + v_rd_base(lane);
  constexpr int SD = DKR ? MLA_SD : 2;
  struct { bf16x8 vs0, vs1, ks0, ks1, kr; } sr_[SD];
#define SLOAD(i, k0) do { sr_[i].vs0 = *reinterpret_cast<const bf16x8*>(&Vh[(long)((k0) + sr) * LDV + sc]); sr_[i].vs1 = *reinterpret_cast<const bf16x8*>(&Vh[(long)((k0) + 32 + sr) * LDV + sc]); \
    sr_[i].ks0 = *reinterpret_cast<const bf16x8*>(&Kh[(long)((k0) + sr) * LDK + sc]); sr_[i].ks1 = *reinterpret_cast<const bf16x8*>(&Kh[(long)((k0) + 32 + sr) * LDK + sc]); \
    if constexpr (DKR > 0) sr_[i].kr = *reinterpret_cast<const bf16x8*>(&Kr[(long)((k0) + krr) * 64 + krc]); } while (0)
#define SWRITE(b, i) do { *(bf16x8*)(V_lds + (b) * SHM_V + vst0) = sr_[i].vs0;          \
    *(bf16x8*)(V_lds + (b) * SHM_V + vst1) = sr_[i].vs1; int kc = sc * 2;               \
    *(bf16x8*)(K_lds + (b) * SHM_K + KSWZ(sr, kc)) = sr_[i].ks0;                       \
    *(bf16x8*)(K_lds + (b) * SHM_K + KSWZ(32 + sr, kc)) = sr_[i].ks1;                  \
    if constexpr (DKR > 0) *(bf16x8*)(KR_lds + (b) * SHM_KR + KRSWZ(krr, krc * 2)) = sr_[i].kr; } while (0)
#define SWAIT() do { if constexpr (SD == 1) asm volatile("s_waitcnt vmcnt(0)" ::: "memory"); else asm volatile("s_waitcnt vmcnt(4)" ::: "memory"); } while (0)
#define RESC(a) do { if (__any((a) < 1.f)) { if (hi == 0) al_l[r32] = (a); asm volatile("s_waitcnt lgkmcnt(0)" ::: "memory"); \
    _Pragma("unroll") for (int d = 0; d < 4; ++d) _Pragma("unroll") for (int r = 0; r < 16; ++r) o[d][r] *= al_l[crow(r, hi)]; } } while (0)
  f32x16 pA0, pA1, pB0, pB1; float mnA, mnB, alA, alB; bf16x8 pa0, pa1, pa2, pa3; const int NT = seq / KVBLK;
  constexpr int SE = 0, SO = SD - 1;
  SLOAD(SE, 0); asm volatile("s_waitcnt vmcnt(0)" ::: "memory"); SWRITE(0, SE); __syncthreads();
  qkt<DKR, NQ>(pA0, pA1, K_lds, KR_lds, QR_lds, qr, r32, hi, lane); partialSM(pA0, pA1, m_reg, mnA, alA, SCALE);
  SLOAD(SO, KVBLK); if constexpr (SD == 2) { if (2 < NT) SLOAD(SE, 2 * KVBLK); }
  SWAIT(); SWRITE(1, SO); __syncthreads();
  for (int j = 1; j + 1 < NT; j += 2) {
    SBAR(); qkt<DKR, NQ>(pB0, pB1, K_lds + SHM_K, KR_lds + SHM_KR, QR_lds, qr, r32, hi, lane);
    finishSM(pA0, pA1, alA, l_reg, pa0, pa1, pa2, pa3); SBAR();
    SLOAD(SO, (j + SD) * KVBLK); SBAR();
    pv_sm(o, vb0, pa0, pa1, pa2, pa3, pB0, pB1, m_reg, mnB, alB, SCALE);
    __syncthreads(); SWAIT(); SWRITE(0, SE);
    RESC(alB); __syncthreads();
    SBAR(); qkt<DKR, NQ>(pA0, pA1, K_lds, KR_lds, QR_lds, qr, r32, hi, lane);
    finishSM(pB0, pB1, alB, l_reg, pa0, pa1, pa2, pa3); SBAR();
    if (SD == 1 || j + 3 < NT) SLOAD(SE, (j + 1 + SD) * KVBLK); SBAR();
    pv_sm(o, vb0 + (int)SHM_V, pa0, pa1, pa2, pa3, pA0, pA1, m_reg, mnA, alA, SCALE);
    __syncthreads(); SWAIT(); SWRITE(1, SO);
    RESC(alA); __syncthreads();
  }
  SBAR(); qkt<DKR, NQ>(pB0, pB1, K_lds + SHM_K, KR_lds + SHM_KR, QR_lds, qr, r32, hi, lane);
  finishSM(pA0, pA1, alA, l_reg, pa0, pa1, pa2, pa3); SBAR();
  pv_sm(o, vb0, pa0, pa1, pa2, pa3, pB0, pB1, m_reg, mnB, alB, SCALE);
  __syncthreads(); RESC(alB);
  finishSM(pB0, pB1, alB, l_reg, pa0, pa1, pa2, pa3); SBAR();
  pv_d0(o, vb0 + (int)SHM_V, pa0, pa1, pa2, pa3);
  if (hi == 0) li_l[r32] = l_reg; asm volatile("s_waitcnt lgkmcnt(0)" ::: "memory");
  float rli[16];
#pragma unroll
  for (int r = 0; r < 16; ++r) rli[r] = __builtin_amdgcn_rcpf(li_l[crow(r, hi)]);
  bf16_t* Ow = Ob + (long)(wid * QBLK) * LDO;
#pragma unroll
  for (int r = 0; r < 16; ++r) { int orow = crow(r, hi);
#pragma unroll
    for (int d0 = 0; d0 < 4; ++d0) Ow[(long)orow * LDO + d0 * 32 + r32] = (bf16_t)(cvtpk(o[d0][r] * rli[r], 0.f) & 0xffffu); }
  __syncthreads();
#undef SLOAD
#undef SWRITE
#undef SWAIT
#undef RESC
}
#undef SBAR
}
typedef pg8::bf16_t bf16_t;
typedef float f32x4 __attribute__((ext_vector_type(4)));
typedef unsigned v4u __attribute__((ext_vector_type(4)));
typedef unsigned v2u __attribute__((ext_vector_type(2)));
#define LAS __attribute__((address_space(3)))
constexpr int NWAVES = 8, NTHR = 512;
constexpr int DM = 2048, NB = 8, SEQ = 2048, CTX = 256, TK = SEQ + CTX  , MLAT = NB * SEQ  , MZ = NB * TK  ;
constexpr int DFF = 5632, NUP = 2 * DFF, NIN = 7168;
constexpr float EPS = 1e-6f;
constexpr size_t MiB = 1u << 20;
constexpr size_t WS_MODP = 0;
constexpr size_t WS_MOD  = 7 * MiB;
constexpr size_t WS_RT64 = 7 * MiB + 440 * 1024, WS_RT128 = WS_RT64 + 8192;
constexpr size_t WS_CTL  = 7 * MiB + 512 * 1024, CTL_BYTES = 16384;
constexpr size_t WS_WUP  = 8 * MiB;
constexpr size_t WS_WDN  = 52 * MiB;
constexpr size_t WS_Z    = 74 * MiB;
constexpr size_t WS_KA   = WS_Z, WS_VA = WS_Z + 36 * MiB, WS_MRG = WS_Z, WS_Z2 = WS_Z;
constexpr size_t WS_WIN  = 146 * MiB;
constexpr size_t WS_WKV  = 174 * MiB;
constexpr size_t WS_WQ   = 176 * MiB;
constexpr size_t WS_WBR  = 179 * MiB;
constexpr size_t WS_WOUT = 187 * MiB;
constexpr size_t WS_ACT  = 195 * MiB;
constexpr size_t WS_CKV  = WS_ACT;
constexpr size_t WS_CQ   = WS_ACT + 18 * MiB;
constexpr size_t WS_OA   = WS_ACT, WS_OB = WS_ACT + 32 * MiB;
constexpr size_t WS_KB   = WS_ACT + 64 * MiB;
constexpr size_t WS_VB   = WS_KB + 9 * MiB;
constexpr size_t WS_KPE  = WS_VB + 9 * MiB;
constexpr size_t WS_QB   = WS_KPE + 3 * MiB;
constexpr size_t WS_GATE = WS_QB + 32 * MiB;
constexpr size_t WS_QA   = WS_GATE + 128 * MiB;
constexpr size_t WS_ATT_END = WS_QA + 48 * MiB;
constexpr size_t WS_X1B = WS_ACT, WS_X2B = WS_Z;
constexpr size_t WS_PART = 146 * MiB, WS_RAWB = 152 * MiB;
constexpr size_t WS_H    = 322 * MiB;
constexpr size_t WS_END  = 498 * MiB;
static_assert(WS_ATT_END <= WS_END && WS_RAWB + 6 * MiB <= WS_H, "ws map");
constexpr int EX_OFF = 131072;
constexpr int MISC_OFF = 157696; constexpr int LDS_BYTES = 157696 + 256; static_assert(att::LDS_BYTES <= LDS_BYTES, "attention LDS");

#define XB_TMO      128
#define XB_XCNT(j)  (256  + 64 * (j))
#define XB_XSUB(j)  (1280 + 64 * (j))
#define XB_XGEN(j)  (2304 + 64 * (j))
#define XB_TOP      3328
#define XB_TOPGEN   3392
#define XCD_BAR_WORDS 3456
#define XB_SPIN_CAP (1u << 18)

__device__ __forceinline__ unsigned xb_ld(unsigned* p)              { return __hip_atomic_load(p, __ATOMIC_RELAXED, __HIP_MEMORY_SCOPE_AGENT); }
__device__ __forceinline__ unsigned xb_add(unsigned* p, unsigned v) { return __hip_atomic_fetch_add(p, v, __ATOMIC_RELAXED, __HIP_MEMORY_SCOPE_AGENT); }
__device__ __forceinline__ unsigned xb_xcc_id() { return (unsigned)__builtin_amdgcn_s_getreg((3 << 11) | 20) & 0xFu; }
#define XB_SPIN(cond, bar) do { unsigned _sp = 0; while (cond) { __builtin_amdgcn_s_sleep(1); \
    if ((++_sp & 255u) == 0u) { if (xb_ld(&(bar)[XB_TMO])) break; if (_sp > XB_SPIN_CAP) { atomicAdd(&(bar)[XB_TMO], 1u); break; } } } } while (0)

struct XcdBarrier {
    unsigned* bar; unsigned x;
    volatile LAS unsigned* st;
};

__device__ __forceinline__ XcdBarrier xcd_barrier_post(unsigned* bar, volatile LAS unsigned* st) {
    XcdBarrier b; b.bar = bar; b.x = xb_xcc_id(); b.st = st;
    if (threadIdx.x == 0) (void)xb_add(&bar[XB_XCNT(b.x)], 1u);
    return b;
}
__device__ __forceinline__ void xcd_barrier_complete(unsigned* bar, unsigned x, unsigned& nloc, unsigned& nx) {
    const unsigned G = gridDim.x * gridDim.y * gridDim.z;
    unsigned sum, cnt, mine, sp = 0u;
    for (;;) {
        sum = 0u; cnt = 0u; mine = 0u;
#pragma unroll
        for (unsigned j = 0; j < 16; ++j) { const unsigned c = xb_ld(&bar[XB_XCNT(j)]); sum += c; cnt += (c > 0u) ? 1u : 0u; mine = (j == x) ? c : mine; }
        if (sum == G) break;
        __builtin_amdgcn_s_sleep(1);
        if ((++sp & 255u) == 0u) { if (xb_ld(&bar[XB_TMO])) break; if (sp > XB_SPIN_CAP) { atomicAdd(&bar[XB_TMO], 1u); break; } }
    }
    nloc = mine > 0u ? mine : 1u; nx = cnt > 0u ? cnt : 1u;
}

__device__ __forceinline__ void xcd_barrier(const XcdBarrier& b) {
    asm volatile("s_waitcnt vmcnt(0)" ::: "memory");
    __syncthreads();
    if (threadIdx.x == 0) {
        unsigned* bar = b.bar;
        __builtin_amdgcn_s_waitcnt(0);
        unsigned nloc = b.st[0], nx = b.st[1];
        if (nloc == 0u) { xcd_barrier_complete(bar, b.x, nloc, nx); b.st[0] = nloc; b.st[1] = nx; }
        const unsigned old = xb_add(&bar[XB_XSUB(b.x)], 1u);
        const unsigned gen = old / nloc;
        if (old + 1u == (gen + 1u) * nloc) {
            __builtin_amdgcn_fence(__ATOMIC_RELEASE, "agent");
            asm volatile("s_waitcnt vmcnt(0)" ::: "memory");
            const unsigned og = xb_add(&bar[XB_TOP], 1u);
            const unsigned tg = og / nx;
            if (og + 1u == (tg + 1u) * nx) xb_add(&bar[XB_TOPGEN], 1u);
            else XB_SPIN(xb_ld(&bar[XB_TOPGEN]) == tg, bar);
            __builtin_amdgcn_fence(__ATOMIC_ACQUIRE, "agent");
            xb_add(&bar[XB_XGEN(b.x)], 1u);
            asm volatile("s_waitcnt vmcnt(0)" ::: "memory");
        } else {
            XB_SPIN(xb_ld(&bar[XB_XGEN(b.x)]) == gen, bar);
            __builtin_amdgcn_fence(__ATOMIC_ACQUIRE, "agent");
            asm volatile("s_waitcnt vmcnt(0)" ::: "memory");
        }
    }
    __syncthreads();
}

struct Args {
    const float *x, *c, *ctx, *c_ctx, *w_ada, *b_ada, *norm1_g, *w_in, *mla_q_norm_g, *w_q_up, *mla_kv_norm_g, *w_kv_up, *gqa_q_norm_g, *gqa_k_norm_g,
                *w_br_a, *w_br_b, *w_out, *norm2_g, *w_up, *conv_w, *conv_b, *w_down, *final_norm_g;
    float* out; unsigned char* ws;
};
__device__ __forceinline__ unsigned f2bf(float f) { unsigned u = __builtin_bit_cast(unsigned, f); return (u + 0x7fffu + ((u >> 16) & 1u)) >> 16; }
__device__ __forceinline__ unsigned pk2(float lo, float hi) { return f2bf(lo) | (f2bf(hi) << 16); }
__device__ __forceinline__ float blo(unsigned w) { return __uint_as_float(w << 16); }
__device__ __forceinline__ float bhi(unsigned w) { return __uint_as_float(w & 0xffff0000u); }
__device__ __forceinline__ float wave_sum(float v) {
#pragma unroll
    for (int o = 1; o < 64; o <<= 1) v += __shfl_xor(v, o);
    return v;
}
__device__ __forceinline__ void transpose_item(const float* W, int N, bf16_t* WT, int Kdst, int koff, int k0, int n0, int drow0, const float* kscale, LAS float* scr, int lane) {
    float tv[32];
#pragma unroll
    for (int i = 0; i < 32; ++i) { const int kk = 2 * i + (lane >> 5); tv[i] = __builtin_nontemporal_load(W + (size_t)(k0 + kk) * N + n0 + (lane & 31)); }
#pragma unroll
    for (int i = 0; i < 32; ++i) { const int kk = 2 * i + (lane >> 5); float v = tv[i]; if (kscale) v *= kscale[k0 + kk]; scr[kk * 33 + (lane & 31)] = v; }
    asm volatile("s_waitcnt lgkmcnt(0)" ::: "memory");
    const int c = lane & 7;
#pragma unroll
    for (int j = 0; j < 4; ++j) { const int n = (lane >> 3) + 8 * j; const LAS float* s = scr + (8 * c) * 33 + n;
        v4u o; o.x = pk2(s[0 * 33], s[1 * 33]); o.y = pk2(s[2 * 33], s[3 * 33]); o.z = pk2(s[4 * 33], s[5 * 33]); o.w = pk2(s[6 * 33], s[7 * 33]);
        *(v4u*)(WT + (size_t)(drow0 + n) * Kdst + koff + k0 + 8 * c) = o; }
    asm volatile("s_waitcnt lgkmcnt(0)" ::: "memory");
}
__device__ __forceinline__ int win_map(int n0) {
    if (n0 < 512) return n0;
    if (n0 < 576) return 1024 + (n0 - 512);
    if (n0 < 832) return 512 + (n0 - 576);
    if (n0 < 1088) return 768 + (n0 - 832);
    if (n0 < 2880) return n0 + 192;
    { const int gi = n0 - 2880, half = gi >= 2048 ? 1 : 0, ch = gi - half * 2048; return 3072 + (ch >> 7) * 256 + half * 128 + (ch & 127); }
}
__device__ __forceinline__ int up_map(int n0) { const int ch = n0 < 5632 ? n0 : n0 - 5632; return (ch >> 7) * 256 + (n0 < 5632 ? 0 : 128) + (ch & 127); }
__device__ __forceinline__ void row_norm_mod(const float* xrow, bf16_t* orow, const float* g, const LAS float* SH, const LAS float* SC, int lane) {
    const f32x4* xr = (const f32x4*)xrow + lane; f32x4 v[8]; float s = 0.f;
#pragma unroll
    for (int j = 0; j < 8; ++j) { v[j] = __builtin_nontemporal_load(xr + 64 * j); s += (v[j].x * v[j].x + v[j].y * v[j].y) + (v[j].z * v[j].z + v[j].w * v[j].w); }
    const float rstd = 1.0f / sqrtf(wave_sum(s) * (1.f / 2048.f) + EPS);
    v2u* o8 = (v2u*)orow + lane;
#pragma unroll
    for (int j = 0; j < 8; ++j) { const int cidx = (lane + 64 * j) * 4; const f32x4 gg = *(const f32x4*)(g + cidx);
        const float a0 = (v[j].x * rstd * gg.x) * (1.f + SC[cidx]) + SH[cidx], a1 = (v[j].y * rstd * gg.y) * (1.f + SC[cidx + 1]) + SH[cidx + 1];
        const float a2 = (v[j].z * rstd * gg.z) * (1.f + SC[cidx + 2]) + SH[cidx + 2], a3 = (v[j].w * rstd * gg.w) * (1.f + SC[cidx + 3]) + SH[cidx + 3];
        v2u w; w.x = pk2(a0, a1); w.y = pk2(a2, a3); o8[64 * j] = w; }
}
__device__ __forceinline__ void row_norm_mod_bf(const bf16_t* xrow, bf16_t* orow, const float* g, const LAS float* SH, const LAS float* SC, int lane) {
    const v4u* xr = (const v4u*)xrow + lane; v4u w[4]; float s = 0.f;
#pragma unroll
    for (int j = 0; j < 4; ++j) { w[j] = xr[64 * j];
#pragma unroll
        for (int e = 0; e < 4; ++e) { const float a = blo(w[j][e]), c = bhi(w[j][e]); s += a * a + c * c; } }
    const float rstd = 1.0f / sqrtf(wave_sum(s) * (1.f / 2048.f) + EPS);
    v4u* o16 = (v4u*)orow + lane;
#pragma unroll
    for (int j = 0; j < 4; ++j) { const int cidx = (lane + 64 * j) * 8; v4u o;
#pragma unroll
        for (int e = 0; e < 4; ++e) { const int c0 = cidx + 2 * e;
            const float a0 = (blo(w[j][e]) * rstd * g[c0]) * (1.f + SC[c0]) + SH[c0], a1 = (bhi(w[j][e]) * rstd * g[c0 + 1]) * (1.f + SC[c0 + 1]) + SH[c0 + 1];
            o[e] = pk2(a0, a1); }
        o16[64 * j] = o; }
}
__device__ __forceinline__ void row_norm_mod_bf2(const bf16_t* xa, bf16_t* oa, const bf16_t* xb, bf16_t* ob, const float* g, const LAS float* SH, const LAS float* SC, int lane) {
    const v4u* pa = (const v4u*)xa + lane; const v4u* pb = (const v4u*)xb + lane; v4u wa[4], wb[4]; float sa = 0.f, sb = 0.f;
#pragma unroll
    for (int j = 0; j < 4; ++j) { wa[j] = pa[64 * j]; wb[j] = pb[64 * j]; }
#pragma unroll
    for (int j = 0; j < 4; ++j)
#pragma unroll
        for (int e = 0; e < 4; ++e) { const float a = blo(wa[j][e]), c = bhi(wa[j][e]), a2 = blo(wb[j][e]), c2 = bhi(wb[j][e]); sa += a * a + c * c; sb += a2 * a2 + c2 * c2; }
#pragma unroll
    for (int o = 1; o < 64; o <<= 1) { sa += __shfl_xor(sa, o); sb += __shfl_xor(sb, o); }
    const float ra = 1.0f / sqrtf(sa * (1.f / 2048.f) + EPS), rb = 1.0f / sqrtf(sb * (1.f / 2048.f) + EPS);
    v4u* qa = (v4u*)oa + lane; v4u* qb = (v4u*)ob + lane;
#pragma unroll
    for (int j = 0; j < 4; ++j) { const int cidx = (lane + 64 * j) * 8; v4u o0, o1;
#pragma unroll
        for (int e = 0; e < 4; ++e) { const int c0 = cidx + 2 * e; const float g0 = g[c0], g1 = g[c0 + 1], m0 = 1.f + SC[c0], m1 = 1.f + SC[c0 + 1], h0 = SH[c0], h1 = SH[c0 + 1];
            o0[e] = pk2((blo(wa[j][e]) * ra * g0) * m0 + h0, (bhi(wa[j][e]) * ra * g1) * m1 + h1);
            o1[e] = pk2((blo(wb[j][e]) * rb * g0) * m0 + h0, (bhi(wb[j][e]) * rb * g1) * m1 + h1); }
        qa[64 * j] = o0; qb[64 * j] = o1; }
}
struct Rope { float c0, s0, c1, s1; };
__device__ __forceinline__ Rope rope_setup(int w, int R, int grow, int gcol, const float* tab) {
    const int q = R / 4, d = 2 * w, axis = d / (2 * q), j = d & (q - 1);
    const int ipos = axis ? gcol : grow;
    const f32x4 cst = *(const f32x4*)(tab + (ipos * q + j) * 2);
    Rope r; r.c0 = cst[0]; r.s0 = cst[1]; r.c1 = cst[2]; r.s1 = cst[3];
    const bool x2 = (d & q) != 0; if (!x2) { r.s0 = -r.s0; r.s1 = -r.s1; }
    return r;
}
#ifndef REP0
#define REP0 1
#endif
#ifndef REP2
#define REP2 1
#endif
#ifndef REP6
#define REP6 1
#endif
__global__ void __launch_bounds__(NTHR, 2) fwd_megakernel(Args A) {
    extern __shared__ __attribute__((aligned(16))) unsigned char lds_raw[];
    cg::grid_group grid = cg::this_grid();
    LAS unsigned char* lds = (LAS unsigned char*)lds_raw;
    const int G = gridDim.x, blk = blockIdx.x, NGW = G * NWAVES;
    { volatile LAS unsigned* mz = (volatile LAS unsigned*)(lds + MISC_OFF); if (threadIdx.x < 64) mz[threadIdx.x] = 0u; }
    __syncthreads();
    grid.sync();
    const XcdBarrier bar = xcd_barrier_post((unsigned*)(A.ws + WS_CTL), (volatile LAS unsigned*)(lds + MISC_OFF) + 8);
#define PHASE_IDS int tid = threadIdx.x; asm volatile("" : "+v"(tid)); const int lane = tid & 63, wave = __builtin_amdgcn_readfirstlane(tid >> 6), gw = blk * NWAVES + wave; (void)lane; (void)gw;
    unsigned char* ws = A.ws;
    float* MODP = (float*)(ws + WS_MODP); float* MOD = (float*)(ws + WS_MOD); float* RT64 = (float*)(ws + WS_RT64); float* RT128 = (float*)(ws + WS_RT128);
    bf16_t* WUP = (bf16_t*)(ws + WS_WUP); bf16_t* WDN = (bf16_t*)(ws + WS_WDN); bf16_t* Z = (bf16_t*)(ws + WS_Z);
    bf16_t* WIN = (bf16_t*)(ws + WS_WIN); bf16_t* WKV = (bf16_t*)(ws + WS_WKV); bf16_t* WQ = (bf16_t*)(ws + WS_WQ); bf16_t* WBR = (bf16_t*)(ws + WS_WBR); bf16_t* WOUT = (bf16_t*)(ws + WS_WOUT);
    bf16_t* CKV = (bf16_t*)(ws + WS_CKV); bf16_t* CQ = (bf16_t*)(ws + WS_CQ); bf16_t* OA = (bf16_t*)(ws + WS_OA); bf16_t* OB = (bf16_t*)(ws + WS_OB); bf16_t* KBm = (bf16_t*)(ws + WS_KB); bf16_t* VBm = (bf16_t*)(ws + WS_VB);
    bf16_t* KPE = (bf16_t*)(ws + WS_KPE); bf16_t* QB = (bf16_t*)(ws + WS_QB); bf16_t* GATE = (bf16_t*)(ws + WS_GATE); bf16_t* QA = (bf16_t*)(ws + WS_QA);
    bf16_t* KA = (bf16_t*)(ws + WS_KA); bf16_t* VA = (bf16_t*)(ws + WS_VA); bf16_t* MRG = (bf16_t*)(ws + WS_MRG); bf16_t* Z2 = (bf16_t*)(ws + WS_Z2);
    bf16_t* X1B = (bf16_t*)(ws + WS_X1B); bf16_t* X2B = (bf16_t*)(ws + WS_X2B);
    float* PART = (float*)(ws + WS_PART); float* RAWB = (float*)(ws + WS_RAWB); bf16_t* H = (bf16_t*)(ws + WS_H);

#if !defined(ONLY) || ONLY==0
    _Pragma("unroll 1") for (int rep0 = 0; rep0 < REP0; ++rep0) {
        PHASE_IDS
        LAS float* S = (LAS float*)lds;
        LAS float* R = (LAS float*)(lds + 8192);
        for (int item = blk; item < 16 * 48; item += G) {
            const int kc = item / 48, nc = item % 48;
            for (int idx = tid; idx < 9 * 128; idx += NTHR) { const int cn = idx >> 7, k = kc * 128 + (idx & 127); const float v = cn < 8 ? A.c[cn * 2048 + k] : A.c_ctx[k]; S[idx] = v / (1.f + __expf(-v)); }
            __syncthreads();
            const int col4 = tid & 63, ks = tid >> 6;
            f32x4 acc[9];
#pragma unroll
            for (int cn = 0; cn < 9; ++cn) acc[cn] = (f32x4){0.f, 0.f, 0.f, 0.f};
            const f32x4* wp = (const f32x4*)(A.w_ada + (size_t)(kc * 128 + ks * 16) * 12288 + nc * 256) + col4;
#pragma unroll 4
            for (int kk = 0; kk < 16; ++kk) { const f32x4 w = __builtin_nontemporal_load(wp + (size_t)kk * 3072);
#pragma unroll
                for (int cn = 0; cn < 9; ++cn) acc[cn] += S[cn * 128 + ks * 16 + kk] * w; }
#pragma unroll
            for (int cn = 0; cn < 9; ++cn) ((LAS f32x4*)R)[(ks * 9 + cn) * 64 + col4] = acc[cn];
            __syncthreads();
            for (int o = tid; o < 9 * 256; o += NTHR) { const int cn = o >> 8, cc = o & 255; float s = 0.f;
#pragma unroll
                for (int k2 = 0; k2 < 8; ++k2) s += R[(k2 * 9 + cn) * 256 + cc];
                MODP[(size_t)(kc * 9 + cn) * 12288 + nc * 256 + cc] = s; }
            __syncthreads();
        }
        LAS float* scr = (LAS float*)(lds + wave * 16384);
        constexpr int I_IN = 32 * 218, I_KV = 8 * 64, I_Q = 12 * 48, I_BR = 16 * 64, I_OUT = 32 * 64, I_UP = 32 * 352, I_DN = 88 * 64;
        constexpr int NITEMS = I_IN + I_KV + I_Q;
        for (int it = gw; it < NITEMS; it += NGW) {
            int r = it;
            if (r < I_IN) { const int nb = r % 218, kb = r / 218; transpose_item(A.w_in, 6976, WIN, 2048, 0, kb * 64, nb * 32, win_map(nb * 32), nullptr, scr, lane); continue; } r -= I_IN;
            if (r < I_KV) { const int nb = r % 64, kb = r / 64; transpose_item(A.w_kv_up, 2048, WKV, 512, 0, kb * 64, nb * 32, nb * 32, A.mla_kv_norm_g, scr, lane); continue; } r -= I_KV;
            { const int nb = r % 48, kb = r / 48; transpose_item(A.w_q_up, 1536, WQ, 768, 0, kb * 64, nb * 32, nb * 32, A.mla_q_norm_g, scr, lane); }
        }
        for (int i = blk * NTHR + tid; i < 64 * 16 + 64 * 32; i += G * NTHR) {
            const bool big = i >= 64 * 16; const int k = big ? i - 64 * 16 : i, q = big ? 32 : 16, pos = k / q, j = k - pos * q;
            float sn, cs; sincosf((float)pos * exp2f(-(float)j * (13.287712379549449f / (float)q)), &sn, &cs);
            float* tp = (big ? RT128 : RT64) + (size_t)k * 2; tp[0] = cs; tp[1] = sn; }
        for (int i = blk * NTHR + tid; i < 192 * 2048 / 8; i += G * NTHR) *(v4u*)(WIN + (size_t)1088 * 2048 + (size_t)i * 8) = (v4u){0u, 0u, 0u, 0u};
        if (REP0 > 1) __syncthreads();
    }
#endif
    xcd_barrier(bar);

#if !defined(ONLY) || ONLY==1
    {
        PHASE_IDS
        LAS float* SH = (LAS float*)lds; LAS float* SC = SH + 2048;
        const bool is_ctx = blk >= 224; const int cn = is_ctx ? 8 : blk / 28, bi = is_ctx ? blk - 224 : blk % 28;
        {
            float sv8[8];
#pragma unroll
            for (int q = 0; q < 8; ++q) sv8[q] = A.b_ada[tid + q * NTHR];
#pragma unroll
            for (int kc = 0; kc < 16; ++kc)
#pragma unroll
                for (int q = 0; q < 8; ++q) sv8[q] += MODP[(size_t)(kc * 9 + cn) * 12288 + tid + q * NTHR];
#pragma unroll
            for (int q = 0; q < 8; ++q) SH[tid + q * NTHR] = sv8[q];
        }
        for (int idx = blk * 432 + tid; idx < (blk + 1) * 432; idx += NTHR) { const int c2 = idx / 12288, col = idx % 12288; float s = A.b_ada[col];
#pragma unroll
            for (int kc = 0; kc < 16; ++kc) s += MODP[(size_t)(kc * 9 + c2) * 12288 + col];
            MOD[idx] = s; }
        __syncthreads();
        if (!is_ctx) { for (int t = bi * 8 + wave; t < SEQ; t += 28 * 8) row_norm_mod(A.x + ((size_t)cn * SEQ + t) * DM, Z + ((size_t)cn * TK + CTX + t) * DM, A.norm1_g, SH, SC, lane); }
        else { for (int cr = bi * 8 + wave; cr < NB * CTX; cr += 32 * 8) { const int b = cr >> 8, j = cr & 255; row_norm_mod(A.ctx + (size_t)cr * DM, Z + ((size_t)b * TK + j) * DM, A.norm1_g, SH, SC, lane); } }
    }
#endif
    xcd_barrier(bar);

#if !defined(ONLY) || ONLY==2
    _Pragma("unroll 1") for (int rep2 = 0; rep2 < REP2; ++rep2) {
        pg8::Gemm g{Z, WIN, MZ, NIN, DM}; pg8::ProjOrder S; S.init(G, blk);
        pg8::EpiProj E{CKV, KBm, VBm, KPE, CQ, QB, GATE};
        pg8::gemm_phase<pg8::EpiProj, pg8::ProjOrder, true, true>(lds, g, S, E);
        const int nfull = 1832 - 7 * G;
        if (G == 256 && blk >= nfull) { PHASE_IDS
            LAS float* scr = (LAS float*)(lds + wave * 16384);
            constexpr int I_UP = 32 * 352, I_DN = 88 * 64;
            const int nw = (G - nfull) * NWAVES;
            for (int it = (blk - nfull) * NWAVES + wave; it < I_UP + I_DN + 4096; it += nw) {
                if (it < I_UP) { const int nb = it % 352, kb = it / 352; transpose_item(A.w_up, 11264, WUP, 2048, 0, kb * 64, nb * 32, up_map(nb * 32), nullptr, scr, lane); }
                else if (it < I_UP + I_DN) { const int r = it - I_UP; const int nb = r % 64, kb = r / 64; transpose_item(A.w_down, 2048, WDN, 5632, 0, kb * 64, nb * 32, nb * 32, nullptr, scr, lane); }
                else { int r = it - I_UP - I_DN; const int which = r / 1024; r -= which * 1024; const int nb = r % 64, kb = r / 64;
                    if (which == 0) transpose_item(A.w_br_a, 2048, WBR, 2048, 0, kb * 64, nb * 32, nb * 32, nullptr, scr, lane);
                    else if (which == 1) transpose_item(A.w_br_b, 2048, WBR, 2048, 1024, kb * 64, nb * 32, nb * 32, nullptr, scr, lane);
                    else transpose_item(A.w_out, 2048, WOUT, 2048, 0, (kb + (which - 2) * 16) * 64, nb * 32, nb * 32, nullptr, scr, lane); }
            }
        } else if (G != 256) { PHASE_IDS
            LAS float* scr = (LAS float*)(lds + wave * 16384);
            constexpr int I_UP = 32 * 352, I_DN = 88 * 64;
            for (int it = gw; it < I_UP + I_DN + 4096; it += NGW) {
                if (it < I_UP) { const int nb = it % 352, kb = it / 352; transpose_item(A.w_up, 11264, WUP, 2048, 0, kb * 64, nb * 32, up_map(nb * 32), nullptr, scr, lane); }
                else if (it < I_UP + I_DN) { const int r = it - I_UP; const int nb = r % 64, kb = r / 64; transpose_item(A.w_down, 2048, WDN, 5632, 0, kb * 64, nb * 32, nb * 32, nullptr, scr, lane); }
                else { int r = it - I_UP - I_DN; const int which = r / 1024; r -= which * 1024; const int nb = r % 64, kb = r / 64;
                    if (which == 0) transpose_item(A.w_br_a, 2048, WBR, 2048, 0, kb * 64, nb * 32, nb * 32, nullptr, scr, lane);
                    else if (which == 1) transpose_item(A.w_br_b, 2048, WBR, 2048, 1024, kb * 64, nb * 32, nb * 32, nullptr, scr, lane);
                    else transpose_item(A.w_out, 2048, WOUT, 2048, 0, (kb + (which - 2) * 16) * 64, nb * 32, nb * 32, nullptr, scr, lane); }
            }
        }
    }
#endif
    xcd_barrier(bar);

#if !defined(ONLY) || ONLY==3
    { PHASE_IDS
    const float gk0 = A.gqa_k_norm_g[2 * lane], gk1 = A.gqa_k_norm_g[2 * lane + 1], gq0 = A.gqa_q_norm_g[2 * lane], gq1 = A.gqa_q_norm_g[2 * lane + 1];
    for (int rz = gw; rz < MZ; rz += NGW) {
        const int b = rz / TK, j = rz - b * TK; const bool lat = j >= CTX; const int t = j - CTX, grow = t >> 6, gcol = t & 63;
        unsigned* pckv = (unsigned*)(CKV + (size_t)rz * 512) + lane; unsigned* pkb = (unsigned*)(KBm + (size_t)rz * 256) + lane; unsigned* pkpe = (unsigned*)(KPE + (size_t)rz * 64) + (lane & 31);
        const size_t rl = (size_t)b * SEQ + (lat ? t : 0);
        unsigned* pcq = (unsigned*)(CQ + rl * 768) + lane; unsigned* pqb = (unsigned*)(QB + rl * 1024) + lane;
        unsigned wckv[4], wkb[2], wkpe, wcq[6], wqb[8];
#pragma unroll
        for (int i = 0; i < 4; ++i) wckv[i] = pckv[64 * i];
#pragma unroll
        for (int hh = 0; hh < 2; ++hh) wkb[hh] = pkb[64 * hh];
        wkpe = *pkpe;
        if (lat) {
#pragma unroll
            for (int i = 0; i < 6; ++i) wcq[i] = pcq[64 * i];
#pragma unroll
            for (int hh = 0; hh < 8; ++hh) wqb[hh] = pqb[64 * hh];
        } else {
#pragma unroll
            for (int i = 0; i < 6; ++i) wcq[i] = 0u;
#pragma unroll
            for (int hh = 0; hh < 8; ++hh) wqb[hh] = 0u;
        }
        Rope r128 = {1.f, 0.f, 1.f, 0.f}, r64 = {1.f, 0.f, 1.f, 0.f};
        if (lat) { r128 = rope_setup(lane, 128, grow, gcol, RT128); r64 = rope_setup(lane & 31, 64, grow, gcol, RT64); }
        float sv[12];
        sv[0] = 0.f;
#pragma unroll
        for (int i = 0; i < 4; ++i) { const float a = blo(wckv[i]), c = bhi(wckv[i]); sv[0] += a * a + c * c; }
#pragma unroll
        for (int hh = 0; hh < 2; ++hh) { const float a = blo(wkb[hh]), c = bhi(wkb[hh]); sv[1 + hh] = a * a + c * c; }
        sv[3] = 0.f;
#pragma unroll
        for (int i = 0; i < 6; ++i) { const float a = blo(wcq[i]), c = bhi(wcq[i]); sv[3] += a * a + c * c; }
#pragma unroll
        for (int hh = 0; hh < 8; ++hh) { const float a = blo(wqb[hh]), c = bhi(wqb[hh]); sv[4 + hh] = a * a + c * c; }
#pragma unroll
        for (int o = 1; o < 64; o <<= 1) {
#pragma unroll
            for (int q = 0; q < 12; ++q) sv[q] += __shfl_xor(sv[q], o); }
        { const float rstd = 1.0f / sqrtf(sv[0] * (1.f / 512.f) + EPS);
#pragma unroll
            for (int i = 0; i < 4; ++i) pckv[64 * i] = pk2(blo(wckv[i]) * rstd, bhi(wckv[i]) * rstd); }
#pragma unroll
        for (int hh = 0; hh < 2; ++hh) { const float rstd = 1.0f / sqrtf(sv[1 + hh] * (1.f / 128.f) + EPS);
            const float a = blo(wkb[hh]) * rstd * gk0, c = bhi(wkb[hh]) * rstd * gk1; const float pa = __shfl_xor(a, 16), pc = __shfl_xor(c, 16);
            pkb[64 * hh] = pk2(a * r128.c0 + pa * r128.s0, c * r128.c1 + pc * r128.s1); }
        { const float a = blo(wkpe), c = bhi(wkpe); const float pa = __shfl_xor(a, 8), pc = __shfl_xor(c, 8);
            if (lat && lane < 32) *pkpe = pk2(a * r64.c0 + pa * r64.s0, c * r64.c1 + pc * r64.s1); }
        if (lat) {
            { const float rstd = 1.0f / sqrtf(sv[3] * (1.f / 768.f) + EPS);
#pragma unroll
                for (int i = 0; i < 6; ++i) pcq[64 * i] = pk2(blo(wcq[i]) * rstd, bhi(wcq[i]) * rstd); }
#pragma unroll
            for (int hh = 0; hh < 8; ++hh) { const float rstd = 1.0f / sqrtf(sv[4 + hh] * (1.f / 128.f) + EPS);
                const float a = blo(wqb[hh]) * rstd * gq0, c = bhi(wqb[hh]) * rstd * gq1; const float pa = __shfl_xor(a, 16), pc = __shfl_xor(c, 16);
                pqb[64 * hh] = pk2(a * r128.c0 + pa * r128.s0, c * r128.c1 + pc * r128.s1); }
        }
    }
    }
#endif
    xcd_barrier(bar);

#if !defined(ONLY) || ONLY==4
    {
        const int xc = blk & 7, jc = blk >> 3;
        { pg8::Gemm g{CQ, WQ, MLAT, 1536, 768}; pg8::ListOrder S{jc < 8 ? jc * 3 : 24 + (jc - 8), jc < 8 ? 3 : 1, 8, xc * 8};
          pg8::EpiPlain E{QA, 1536};
          pg8::gemm_phase<pg8::EpiPlain, pg8::ListOrder, true, true>(lds, g, S, E); }
        if (jc >= 8) { pg8::Gemm g{CKV, WKV, MZ, 2048, 512}; pg8::ListOrder S{(jc - 8) * 3, 3, 9, xc * 9};
          pg8::EpiKV E{KA, VA};
          pg8::gemm_phase<pg8::EpiKV, pg8::ListOrder, true, true>(lds, g, S, E); }
    }
#endif
    xcd_barrier(bar);

#if !defined(ONLY) || ONLY==6
    _Pragma("unroll 1") for (int rep6 = 0; rep6 < REP6; ++rep6) {
        const int b = blk & 7, jc = blk >> 3, qb = jc & 7; char* al = (char*)lds_raw;
        const size_t qrow = (size_t)b * SEQ + qb * 256, krow = (size_t)b * TK;
#if !defined(ATTV) || ATTV==0
#pragma unroll 1
        for (int i = 0; i < 2; ++i) { const int h = (jc >> 3) + 4 * i;
            att::attn_unit<64, 1536, 1024, 1024, 2048>(QA + qrow * 1536 + h * 192, KA + krow * 1024 + h * 128, KPE + krow * 64, VA + krow * 1024 + h * 128, OA + qrow * 2048 + h * 128, TK, al, qb * 256, RT64); }
#endif
#if !defined(ATTV) || ATTV==1
#pragma unroll 1
        for (int i = 0; i < 2; ++i) { const int h = (jc >> 3) + 4 * i, kvh = h >> 2;
            att::attn_unit<0, 1024, 256, 256, 2048>(QB + qrow * 1024 + h * 128, KBm + krow * 256 + kvh * 128, nullptr, VBm + krow * 256 + kvh * 128, OA + qrow * 2048 + 1024 + h * 128, TK, al, qb * 256, RT64); }
#endif
    }
#endif
    xcd_barrier(bar);

#if !defined(ONLY) || ONLY==7
    {
        pg8::StaticOrder S; S.init(MLAT, DM, G, blk);
        { pg8::Gemm g{OA, WBR, MLAT, DM, DM}; pg8::EpiBrH E{GATE, MRG}; pg8::gemm_phase<pg8::EpiBrH, pg8::StaticOrder, true, true>(lds, g, S, E); }
    }
#endif
    xcd_barrier(bar);

#if !defined(ONLY) || ONLY==8
    {
        pg8::Gemm g{MRG, WOUT, MLAT, DM, DM}; pg8::StaticOrder S; S.init(MLAT, DM, G, blk);
        pg8::EpiResB<float> E{A.x, X1B, MOD + 4096};
        pg8::gemm_phase<pg8::EpiResB<float>, pg8::StaticOrder, true, true>(lds, g, S, E);
    }
#endif
    xcd_barrier(bar);

#if !defined(ONLY) || ONLY==9
    {
        PHASE_IDS
        LAS float* SH = (LAS float*)lds; LAS float* SC = SH + 2048;
        const int nper = G / 8, cn = blk / nper, bi = blk % nper;
        for (int idx = tid; idx < 4096; idx += NTHR) SH[idx] = MOD[(size_t)cn * 12288 + 6144 + idx];
        __syncthreads();
        if (cn < 8) { const int st = nper * 8;
            for (int t = bi * 8 + wave; t < SEQ; t += 2 * st) { const int t2 = t + st;
                if (t2 < SEQ) row_norm_mod_bf2(X1B + ((size_t)cn * SEQ + t) * DM, Z2 + ((size_t)cn * SEQ + t) * DM, X1B + ((size_t)cn * SEQ + t2) * DM, Z2 + ((size_t)cn * SEQ + t2) * DM, A.norm2_g, SH, SC, lane);
                else row_norm_mod_bf(X1B + ((size_t)cn * SEQ + t) * DM, Z2 + ((size_t)cn * SEQ + t) * DM, A.norm2_g, SH, SC, lane); } }
    }
#endif
    xcd_barrier(bar);

#if !defined(ONLY) || ONLY==10
    {
        pg8::Gemm g{Z2, WUP, MLAT, NUP, DM}; pg8::StaticOrder S; S.init(MLAT, NUP, G, blk);
        pg8::EpiUpConv E{H, A.conv_w, A.conv_b, PART, RAWB, (LAS float*)(lds + EX_OFF)};
        pg8::gemm_phase<pg8::EpiUpConv, pg8::StaticOrder, true, true>(lds, g, S, E);
    }
#endif
    xcd_barrier(bar);
#if !defined(ONLY) || ONLY==11
    { PHASE_IDS
    for (int it = gw; it < 112 * 22; it += NGW) {
        const int rowi = it / 22, cc = it - rowi * 22, b = rowi / 14, k = rowi - b * 14, jb = k >> 1, s = k & 1;
        const int pm = 8 * b + jb + s, side = s ? 0 : 1, nb = s ? pm - 1 : pm + 1, tap = s ? 0 : 2;
        const int ch = cc * 256 + lane * 4, pn = ch >> 7, cl = ch & 127, col = pn * 256 + cl;
        const float* pp = PART + (size_t)(pm * 2 + side) * 11264 + col; const float* rp = RAWB + (size_t)(nb * 2 + (1 - side)) * 11264 + col;
        const f32x4 ca = *(const f32x4*)pp + *(const f32x4*)(A.conv_w + (size_t)tap * 11264 + ch) * *(const f32x4*)rp;
        const f32x4 cbv = *(const f32x4*)(pp + 128) + *(const f32x4*)(A.conv_w + (size_t)tap * 11264 + 5632 + ch) * *(const f32x4*)(rp + 128);
        const f32x4 h = pg8::silu4(ca) * cbv;
        v2u w; w.x = pk2(h[0], h[1]); w.y = pk2(h[2], h[3]);
        *(v2u*)(H + (size_t)(pm * 256 + (side ? 255 : 0)) * DFF + ch) = w;
    }
    }
#endif
    xcd_barrier(bar);

#if !defined(ONLY) || ONLY==12
    {
        pg8::Gemm g{H, WDN, MLAT, DM, DFF}; pg8::StaticOrder S; S.init(MLAT, DM, G, blk);
        pg8::EpiResB<bf16_t> E{X1B, X2B, MOD + 10240};
        pg8::gemm_phase<pg8::EpiResB<bf16_t>, pg8::StaticOrder, true, true>(lds, g, S, E);
    }
#endif
    xcd_barrier(bar);

#if !defined(ONLY) || ONLY==13
    { PHASE_IDS
    for (int r0 = gw; r0 < MLAT; r0 += 2 * NGW) {
        const int r1 = (r0 + NGW < MLAT) ? r0 + NGW : r0;
        const v4u* xa = (const v4u*)(X2B + (size_t)r0 * DM) + lane; const v4u* xb = (const v4u*)(X2B + (size_t)r1 * DM) + lane; v4u wa[4], wb[4]; float sa = 0.f, sb = 0.f;
#pragma unroll
        for (int j = 0; j < 4; ++j) { wa[j] = __builtin_nontemporal_load(xa + 64 * j); wb[j] = __builtin_nontemporal_load(xb + 64 * j); }
#pragma unroll
        for (int j = 0; j < 4; ++j)
#pragma unroll
            for (int e = 0; e < 4; ++e) { const float a = blo(wa[j][e]), c = bhi(wa[j][e]), a2 = blo(wb[j][e]), c2 = bhi(wb[j][e]); sa += a * a + c * c; sb += a2 * a2 + c2 * c2; }
#pragma unroll
        for (int o = 1; o < 64; o <<= 1) { sa += __shfl_xor(sa, o); sb += __shfl_xor(sb, o); }
        const float ra = 1.0f / sqrtf(sa * (1.f / 2048.f) + EPS), rb = 1.0f / sqrtf(sb * (1.f / 2048.f) + EPS);
#pragma unroll
        for (int j = 0; j < 4; ++j) { const int cidx = (lane + 64 * j) * 8; const f32x4 g0 = *(const f32x4*)(A.final_norm_g + cidx), g1 = *(const f32x4*)(A.final_norm_g + cidx + 4);
            f32x4 o0, o1; o0[0] = blo(wa[j][0]); o0[1] = bhi(wa[j][0]); o0[2] = blo(wa[j][1]); o0[3] = bhi(wa[j][1]); o1[0] = blo(wa[j][2]); o1[1] = bhi(wa[j][2]); o1[2] = blo(wa[j][3]); o1[3] = bhi(wa[j][3]);
            f32x4* op = (f32x4*)(A.out + (size_t)r0 * DM + cidx); __builtin_nontemporal_store(o0 * ra * g0, op); __builtin_nontemporal_store(o1 * ra * g1, op + 1);
            if (r1 != r0) { o0[0] = blo(wb[j][0]); o0[1] = bhi(wb[j][0]); o0[2] = blo(wb[j][1]); o0[3] = bhi(wb[j][1]); o1[0] = blo(wb[j][2]); o1[1] = bhi(wb[j][2]); o1[2] = blo(wb[j][3]); o1[3] = bhi(wb[j][3]);
                f32x4* op2 = (f32x4*)(A.out + (size_t)r1 * DM + cidx); __builtin_nontemporal_store(o0 * rb * g0, op2); __builtin_nontemporal_store(o1 * rb * g1, op2 + 1); } }
    }
    }
#endif
}

extern "C" void kernel_launch(void* const* d_in, const int* in_sizes, int n_in, void* d_out, int out_size, void* d_ws, size_t ws_size, hipStream_t stream) {
    static int grid = 0;
    if (grid == 0) {
        if (n_in != 23 || out_size != MLAT * DM || ws_size < WS_END) { fprintf(stderr, "kernel_launch: unexpected shapes n_in %d out %d ws %zu (need %zu)\n", n_in, out_size, ws_size, (size_t)WS_END); grid = -1; return; }
        int dev = 0, cus = 0, per_cu = 0;
        hipGetDevice(&dev); hipDeviceGetAttribute(&cus, hipDeviceAttributeMultiprocessorCount, dev);
        if (hipFuncSetAttribute((const void*)fwd_megakernel, hipFuncAttributeMaxDynamicSharedMemorySize, LDS_BYTES) != hipSuccess) { fprintf(stderr, "kernel_launch: hipFuncSetAttribute failed\n"); grid = -1; return; }
        if (hipOccupancyMaxActiveBlocksPerMultiprocessor(&per_cu, (const void*)fwd_megakernel, NTHR, LDS_BYTES) != hipSuccess || per_cu < 1) { fprintf(stderr, "kernel_launch: occupancy query failed (%d)\n", per_cu); grid = -1; return; }
        grid = cus;
        if (grid != 256) fprintf(stderr, "kernel_launch: %d CUs; this kernel's schedules assume 256\n", grid);
    }
    if (grid < 0) return;
    if (hipMemsetAsync((char*)d_ws + WS_CTL, 0, CTL_BYTES, stream) != hipSuccess) { fprintf(stderr, "kernel_launch: memset failed\n"); return; }
    Args a{};
    const float** ap = (const float**)&a;
    for (int i = 0; i < 23; ++i) ap[i] = (const float*)d_in[i];
    a.out = (float*)d_out; a.ws = (unsigned char*)d_ws;
    void* args[] = {&a};
    hipError_t e = hipLaunchCooperativeKernel((const void*)fwd_megakernel, dim3(grid), dim3(NTHR), args, LDS_BYTES, stream);
    if (e != hipSuccess) fprintf(stderr, "cooperative launch failed: %s (grid %d)\n", hipGetErrorString(e), grid);
}
```

```cpp
#include <hip/hip_runtime.h>
#include <hip/hip_cooperative_groups.h>
#include <cstdio>
#include <cstdint>
namespace cg = cooperative_groups;
namespace pg8 {
#define PG8_LAS __attribute__((address_space(3)))
typedef unsigned short bf16_t;
typedef short bf16x8 __attribute__((ext_vector_type(8)));
typedef float f32x4 __attribute__((ext_vector_type(4)));
typedef unsigned u32x4 __attribute__((ext_vector_type(4)));
constexpr int BM = 256, BK = 64, HALF = 128, HTB = HALF * BK * 2  , STAGE_BYTES = 8 * HTB, NXCD = 8, WGM = 8;

__host__ __device__ __forceinline__ int lds_byte(int r, int c) { const int st = (r >> 4) * 2 + (c >> 5), rr = r & 15, cc = c & 31, ob = rr * 64 + cc * 2; return st * 1024 + (ob ^ (((ob >> 9) & 1) << 5)); }
__host__ __device__ __forceinline__ void stage_rc(int b, int& R, int& C) { const int st = b / 1024, sb = b % 1024, swz = sb ^ (((sb >> 9) & 1) << 5); R = (st >> 1) * 16 + swz / 64; C = (st & 1) * 32 + (swz % 64) / 2; }
__host__ __device__ __forceinline__ int perm32(int rho) { const int n = rho >> 4, i = rho & 15; return 8 * (i >> 2) + 4 * n + (i & 3); }

struct Unit { int pm, pn; };
struct Gemm { const bf16_t* A; const bf16_t* Bt; int M, N, K; };

struct StaticOrder {
    int nM, nN, nwg, G, c;
    __host__ __device__ void init(int M, int N, int G_, int c_) { nM = M / BM; nN = N / BM; nwg = nM * nN; G = G_; c = c_; }
    __host__ __device__ bool next(int i, Unit& u) const {
        const long L = (long)i * G + c; if (L >= nwg) return false;
        int wgid = (int)L; { const int q = nwg / NXCD, r = nwg % NXCD, xcd = wgid % NXCD, off = wgid / NXCD; wgid = (xcd < r ? xcd * (q + 1) : r * (q + 1) + (xcd - r) * q) + off; }
        const int nig = WGM * nN, gid = wgid / nig, fm = gid * WGM, gsz = (nM - fm) < WGM ? (nM - fm) : WGM;
        u.pm = fm + ((wgid % nig) % gsz); u.pn = (wgid % nig) / gsz; return true;
    }
    __device__ __forceinline__ void a_ready(const Unit&) const {}
    __device__ __forceinline__ void done(const Unit&) const {}
};

__device__ __forceinline__ unsigned cvt_pk_bf16(float lo, float hi) { unsigned r; asm volatile("v_cvt_pk_bf16_f32 %0, %1, %2" : "=v"(r) : "v"(lo), "v"(hi)); return r; }
typedef float f32x2 __attribute__((ext_vector_type(2)));
}
namespace pg8 {
__device__ __forceinline__ float bf2f(unsigned short h) { return __uint_as_float((unsigned)h << 16); }
__device__ __forceinline__ float bflo(unsigned w) { return __uint_as_float(w << 16); }
__device__ __forceinline__ float bfhi(unsigned w) { return __uint_as_float(w & 0xffff0000u); }
struct EpiPlain {
    static constexpr bool PERM = true, AFTER_DRAIN = false, HAS_MID = false;
    bf16_t* O; int ldc;
    __device__ __forceinline__ void operator()(const f32x4 (&acc)[2][2][4][2], const Unit& u, int wr, int wc, int fr, int fq) const {
        const int row0 = u.pm * BM + wr * 64 + fr, col0 = u.pn * BM + wc * 32 + 8 * fq;
#pragma unroll
        for (int ai = 0; ai < 2; ++ai)
#pragma unroll
            for (int m = 0; m < 4; ++m) { bf16_t* rowp = O + (size_t)(row0 + ai * HALF + m * 16) * ldc + col0;
#pragma unroll
                for (int bj = 0; bj < 2; ++bj) { const f32x4 v0 = acc[ai][bj][m][0], v1 = acc[ai][bj][m][1];
                    u32x4 w; w.x = cvt_pk_bf16(v0[0], v0[1]); w.y = cvt_pk_bf16(v0[2], v0[3]); w.z = cvt_pk_bf16(v1[0], v1[1]); w.w = cvt_pk_bf16(v1[2], v1[3]);
                    *(u32x4*)(rowp + bj * HALF) = w; } }
    }
};
struct EpiProj {
    static constexpr bool PERM = true, AFTER_DRAIN = false, HAS_MID = false;
    bf16_t *ckv, *kb, *vb, *kpe, *cq, *qb, *gates;
    __device__ __forceinline__ void operator()(const f32x4 (&acc)[2][2][4][2], const Unit& u, int wr, int wc, int fr, int fq) const {
        const int pn = u.pn, bb = u.pm / 9, jj = u.pm - bb * 9;
        const int rowz0 = u.pm * BM, rowl0 = (bb * 8 + jj - 1) * BM;
        bf16_t* base; int ld, row0, maxcol = 256; bool sig = false;
        if (pn < 2)       { base = ckv + pn * 256; ld = 512; row0 = rowz0; }
        else if (pn == 2) { base = kb; ld = 256; row0 = rowz0; }
        else if (pn == 3) { base = vb; ld = 256; row0 = rowz0; }
        else if (pn == 4) { base = kpe; ld = 64; row0 = rowz0; maxcol = 64; }
        else if (pn < 8)  { base = cq + (pn - 5) * 256; ld = 768; row0 = rowl0; }
        else if (pn < 12) { base = qb + (pn - 8) * 256; ld = 1024; row0 = rowl0; }
        else              { base = gates + (pn - 12) * 256; ld = 4096; row0 = rowl0; sig = true; }
        row0 += wr * 64 + fr; const int col0 = wc * 32 + 8 * fq;
        if (sig) {
            bf16_t* gbase = gates + (pn - 12) * 128 + col0;
#pragma unroll
            for (int ai = 0; ai < 2; ++ai)
#pragma unroll
                for (int m = 0; m < 4; ++m) { bf16_t* rowp = gbase + (size_t)(row0 + ai * HALF + m * 16) * 4096; f32x4 rt[2], gb[2];
#pragma unroll
                    for (int n = 0; n < 2; ++n)
#pragma unroll
                        for (int e = 0; e < 4; ++e) { const float ea = __builtin_amdgcn_exp2f(-1.4426950408889634f * acc[ai][0][m][n][e]), eb = __builtin_amdgcn_exp2f(-1.4426950408889634f * acc[ai][1][m][n][e]);
                            gb[n][e] = __builtin_amdgcn_rcpf(1.f + eb); rt[n][e] = (1.f + eb) * __builtin_amdgcn_rcpf(1.f + ea); }
                    u32x4 w; w.x = cvt_pk_bf16(rt[0][0], rt[0][1]); w.y = cvt_pk_bf16(rt[0][2], rt[0][3]); w.z = cvt_pk_bf16(rt[1][0], rt[1][1]); w.w = cvt_pk_bf16(rt[1][2], rt[1][3]);
                    __builtin_nontemporal_store(w, (u32x4*)rowp);
                    w.x = cvt_pk_bf16(gb[0][0], gb[0][1]); w.y = cvt_pk_bf16(gb[0][2], gb[0][3]); w.z = cvt_pk_bf16(gb[1][0], gb[1][1]); w.w = cvt_pk_bf16(gb[1][2], gb[1][3]);
                    __builtin_nontemporal_store(w, (u32x4*)(rowp + 2048)); }
            return;
        }
#pragma unroll
        for (int ai = 0; ai < 2; ++ai)
#pragma unroll
            for (int m = 0; m < 4; ++m) { bf16_t* rowp = base + (size_t)(row0 + ai * HALF + m * 16) * ld + col0;
#pragma unroll
                for (int bj = 0; bj < 2; ++bj) { if (col0 + bj * HALF < maxcol) { f32x4 v0 = acc[ai][bj][m][0], v1 = acc[ai][bj][m][1];
                    if (sig) {
#pragma unroll
                        for (int e = 0; e < 4; ++e) { v0[e] = __builtin_amdgcn_rcpf(1.f + __builtin_amdgcn_exp2f(-1.4426950408889634f * v0[e])); v1[e] = __builtin_amdgcn_rcpf(1.f + __builtin_amdgcn_exp2f(-1.4426950408889634f * v1[e])); } }
                    u32x4 w; w.x = cvt_pk_bf16(v0[0], v0[1]); w.y = cvt_pk_bf16(v0[2], v0[3]); w.z = cvt_pk_bf16(v1[0], v1[1]); w.w = cvt_pk_bf16(v1[2], v1[3]);
                    if (sig) __builtin_nontemporal_store(w, (u32x4*)(rowp + bj * HALF)); else *(u32x4*)(rowp + bj * HALF) = w; } } }
    }
};
struct EpiKV {
    static constexpr bool PERM = true, AFTER_DRAIN = false, HAS_MID = false;
    bf16_t *ka, *va;
    __device__ __forceinline__ void operator()(const f32x4 (&acc)[2][2][4][2], const Unit& u, int wr, int wc, int fr, int fq) const {
        const int row0 = u.pm * BM + wr * 64 + fr, col0 = u.pn * 128 + wc * 32 + 8 * fq;
#pragma unroll
        for (int ai = 0; ai < 2; ++ai)
#pragma unroll
            for (int m = 0; m < 4; ++m) { const size_t off = (size_t)(row0 + ai * HALF + m * 16) * 1024 + col0;
#pragma unroll
                for (int bj = 0; bj < 2; ++bj) { const f32x4 v0 = acc[ai][bj][m][0], v1 = acc[ai][bj][m][1];
                    u32x4 w; w.x = cvt_pk_bf16(v0[0], v0[1]); w.y = cvt_pk_bf16(v0[2], v0[3]); w.z = cvt_pk_bf16(v1[0], v1[1]); w.w = cvt_pk_bf16(v1[2], v1[3]);
                    *(u32x4*)((bj ? va : ka) + off) = w; } }
    }
};
template <int PASS> struct EpiBr {
    static constexpr bool PERM = true, AFTER_DRAIN = false, HAS_MID = false;
    const bf16_t* gates; bf16_t* O;
    __device__ __forceinline__ void operator()(const f32x4 (&acc)[2][2][4][2], const Unit& u, int wr, int wc, int fr, int fq) const {
        const int row0 = u.pm * BM + wr * 64 + fr, col0 = u.pn * BM + wc * 32 + 8 * fq;
#pragma unroll
        for (int ai = 0; ai < 2; ++ai)
#pragma unroll
            for (int m = 0; m < 4; ++m) { const size_t r = (size_t)(row0 + ai * HALF + m * 16);
#pragma unroll
                for (int bj = 0; bj < 2; ++bj) { const u32x4 b = *(const u32x4*)(gates + r * 4096 + PASS * 2048 + col0 + bj * HALF);
                    f32x4 v0 = acc[ai][bj][m][0], v1 = acc[ai][bj][m][1];
                    v0[0] *= bflo(b[0]); v0[1] *= bfhi(b[0]); v0[2] *= bflo(b[1]); v0[3] *= bfhi(b[1]); v1[0] *= bflo(b[2]); v1[1] *= bfhi(b[2]); v1[2] *= bflo(b[3]); v1[3] *= bfhi(b[3]);
                    if (PASS == 1) { const u32x4 t = *(const u32x4*)(O + r * 2048 + col0 + bj * HALF);
                        v0[0] += bflo(t[0]); v0[1] += bfhi(t[0]); v0[2] += bflo(t[1]); v0[3] += bfhi(t[1]); v1[0] += bflo(t[2]); v1[1] += bfhi(t[2]); v1[2] += bflo(t[3]); v1[3] += bfhi(t[3]); }
                    u32x4 w; w.x = cvt_pk_bf16(v0[0], v0[1]); w.y = cvt_pk_bf16(v0[2], v0[3]); w.z = cvt_pk_bf16(v1[0], v1[1]); w.w = cvt_pk_bf16(v1[2], v1[3]);
                    *(u32x4*)(O + r * 2048 + col0 + bj * HALF) = w; }
                asm volatile("" ::: "memory"); }
    }
};
template <int CTRL> __device__ __forceinline__ float dppf(float old, float src) { return __int_as_float(__builtin_amdgcn_update_dpp(__float_as_int(old), __float_as_int(src), CTRL, 0xf, 0xf, false)); }
template <int CTRL> __device__ __forceinline__ f32x4 dpp4(f32x4 old, f32x4 src) { f32x4 r; r[0] = dppf<CTRL>(old[0], src[0]); r[1] = dppf<CTRL>(old[1], src[1]); r[2] = dppf<CTRL>(old[2], src[2]); r[3] = dppf<CTRL>(old[3], src[3]); return r; }
__device__ __forceinline__ f32x4 silu4(f32x4 x) { f32x4 r;
#pragma unroll
    for (int e = 0; e < 4; ++e) r[e] = x[e] * __builtin_amdgcn_rcpf(1.f + __builtin_amdgcn_exp2f(-1.4426950408889634f * x[e]));
    return r; }
struct EpiUpConv {
    static constexpr bool PERM = true, AFTER_DRAIN = false, HAS_MID = false;
    bf16_t* H; const float* cw; const float* cb; float* PART; float* RAWB; PG8_LAS float* EX;
    __device__ __forceinline__ void operator()(const f32x4 (&acc)[2][2][4][2], const Unit& u, int wr, int wc, int fr, int fq) const {
        const int cl0 = wc * 32 + 8 * fq;
        if (fr == 0) {
#pragma unroll
            for (int ai = 0; ai < 2; ++ai)
#pragma unroll
                for (int bj = 0; bj < 2; ++bj)
#pragma unroll
                    for (int n = 0; n < 2; ++n) *(PG8_LAS f32x4*)(EX + ((2 * ai + wr) * 2 + 0) * 256 + 128 * bj + cl0 + 4 * n) = acc[ai][bj][0][n];
        }
        if (fr == 15) {
#pragma unroll
            for (int ai = 0; ai < 2; ++ai)
#pragma unroll
                for (int bj = 0; bj < 2; ++bj)
#pragma unroll
                    for (int n = 0; n < 2; ++n) *(PG8_LAS f32x4*)(EX + ((2 * ai + wr) * 2 + 1) * 256 + 128 * bj + cl0 + 4 * n) = acc[ai][bj][3][n];
        }
        asm volatile("s_waitcnt lgkmcnt(0)" ::: "memory"); __builtin_amdgcn_s_barrier(); asm volatile("" ::: "memory");
        typedef unsigned u32x2 __attribute__((ext_vector_type(2)));
        u32x2 pk0[2][4];
        const f32x4 z4 = (f32x4){0.f, 0.f, 0.f, 0.f};
#pragma unroll
        for (int n = 0; n < 2; ++n) {
            const int ch = u.pn * 128 + cl0 + 4 * n;
            const f32x4 w0a = *(const f32x4*)(cw + ch), w1a = *(const f32x4*)(cw + 11264 + ch), w2a = *(const f32x4*)(cw + 2 * 11264 + ch);
            const f32x4 w0b = *(const f32x4*)(cw + 5632 + ch), w1b = *(const f32x4*)(cw + 11264 + 5632 + ch), w2b = *(const f32x4*)(cw + 2 * 11264 + 5632 + ch);
            const f32x4 ba = *(const f32x4*)(cb + ch), bb = *(const f32x4*)(cb + 5632 + ch);
#pragma unroll
            for (int ai = 0; ai < 2; ++ai) {
                const int q = 2 * ai + wr;
                f32x4 haf = z4, hbf = z4, hal = z4, hbl = z4;
                if (q > 0) { haf = *(const PG8_LAS f32x4*)(EX + ((q - 1) * 2 + 1) * 256 + cl0 + 4 * n); hbf = *(const PG8_LAS f32x4*)(EX + ((q - 1) * 2 + 1) * 256 + 128 + cl0 + 4 * n); }
                if (q < 3) { hal = *(const PG8_LAS f32x4*)(EX + ((q + 1) * 2) * 256 + cl0 + 4 * n); hbl = *(const PG8_LAS f32x4*)(EX + ((q + 1) * 2) * 256 + 128 + cl0 + 4 * n); }
#pragma unroll
                for (int m = 0; m < 4; ++m) {
                    const f32x4 va = acc[ai][0][m][n], vb = acc[ai][1][m][n];
                    f32x4 xa, xb, ya, yb;
                    if (m == 0) { xa = haf; xb = hbf; } else { xa = dpp4<0x121>(va, acc[ai][0][m - 1][n]); xb = dpp4<0x121>(vb, acc[ai][1][m - 1][n]); }
                    if (m == 3) { ya = hal; yb = hbl; } else { ya = dpp4<0x12F>(va, acc[ai][0][m + 1][n]); yb = dpp4<0x12F>(vb, acc[ai][1][m + 1][n]); }
                    const f32x4 pa = dpp4<0x111>(xa, va), pb = dpp4<0x111>(xb, vb);
                    const f32x4 na = dpp4<0x101>(ya, va), nb = dpp4<0x101>(yb, vb);
                    const f32x4 ca = ba + w0a * pa + w1a * va + w2a * na, cbv = bb + w0b * pb + w1b * vb + w2b * nb;
                    if (q == 0 && m == 0) { if (fr == 0) { const size_t o = (size_t)(u.pm * 2 + 0) * 11264 + u.pn * 256 + cl0 + 4 * n;
                        *(f32x4*)(PART + o) = ca; *(f32x4*)(PART + o + 128) = cbv; *(f32x4*)(RAWB + o) = va; *(f32x4*)(RAWB + o + 128) = vb; } }
                    if (q == 3 && m == 3) { if (fr == 15) { const size_t o = (size_t)(u.pm * 2 + 1) * 11264 + u.pn * 256 + cl0 + 4 * n;
                        *(f32x4*)(PART + o) = ca; *(f32x4*)(PART + o + 128) = cbv; *(f32x4*)(RAWB + o) = va; *(f32x4*)(RAWB + o + 128) = vb; } }
                    const f32x4 h = silu4(ca) * cbv;
                    u32x2 pk; pk.x = cvt_pk_bf16(h[0], h[1]); pk.y = cvt_pk_bf16(h[2], h[3]);
                    if (n == 0) pk0[ai][m] = pk;
                    else { u32x4 w; w.x = pk0[ai][m].x; w.y = pk0[ai][m].y; w.z = pk.x; w.w = pk.y;
                        __builtin_nontemporal_store(w, (u32x4*)(H + (size_t)(u.pm * BM + ai * HALF + wr * 64 + m * 16 + fr) * 5632 + u.pn * 128 + cl0)); }
                }
            }
        }
    }
};
struct EpiBrH {
    static constexpr bool PERM = true, AFTER_DRAIN = false, HAS_MID = true;
    const bf16_t* gates; bf16_t* O;
    __device__ __forceinline__ void mid(f32x4 (&acc)[2][2][4][2], const Unit& u, int wr, int wc, int fr, int fq) const {
        int row0 = u.pm * BM + wr * 64 + fr, col0 = u.pn * BM + wc * 32 + 8 * fq;
        asm volatile("" : "+v"(row0), "+v"(col0) :: "memory");
#pragma unroll
        for (int ai = 0; ai < 2; ++ai)
#pragma unroll
            for (int m = 0; m < 4; ++m) {
                int roff = row0 + ai * HALF + m * 16; asm volatile("" : "+v"(roff) :: "memory"); const bf16_t* gp = gates + (size_t)roff * 4096 + col0;
#pragma unroll
                for (int bj = 0; bj < 2; ++bj) { const u32x4 a = __builtin_nontemporal_load((const u32x4*)(gp + bj * HALF));
                    f32x4 r0, r1;
                    r0[0] = bflo(a[0]); r0[1] = bfhi(a[0]); r0[2] = bflo(a[1]); r0[3] = bfhi(a[1]); r1[0] = bflo(a[2]); r1[1] = bfhi(a[2]); r1[2] = bflo(a[3]); r1[3] = bfhi(a[3]);
                    acc[ai][bj][m][0] = acc[ai][bj][m][0] * r0; acc[ai][bj][m][1] = acc[ai][bj][m][1] * r1; }
                asm volatile("" : "+v"(acc[ai][0][m][0]), "+v"(acc[ai][0][m][1]), "+v"(acc[ai][1][m][0]), "+v"(acc[ai][1][m][1]));
                __builtin_amdgcn_sched_barrier(0);
            }
    }
    __device__ __forceinline__ void operator()(const f32x4 (&acc)[2][2][4][2], const Unit& u, int wr, int wc, int fr, int fq) const {
        const int row0 = u.pm * BM + wr * 64 + fr, col0 = u.pn * BM + wc * 32 + 8 * fq;
#pragma unroll
        for (int ai = 0; ai < 2; ++ai)
#pragma unroll
            for (int m = 0; m < 4; ++m) { const size_t r = (size_t)(row0 + ai * HALF + m * 16);
#pragma unroll
                for (int bj = 0; bj < 2; ++bj) { const u32x4 b = *(const u32x4*)(gates + r * 4096 + 2048 + col0 + bj * HALF);
                    const f32x4 v0 = acc[ai][bj][m][0], v1 = acc[ai][bj][m][1];
                    u32x4 w; w.x = cvt_pk_bf16(v0[0] * bflo(b[0]), v0[1] * bfhi(b[0])); w.y = cvt_pk_bf16(v0[2] * bflo(b[1]), v0[3] * bfhi(b[1]));
                    w.z = cvt_pk_bf16(v1[0] * bflo(b[2]), v1[1] * bfhi(b[2])); w.w = cvt_pk_bf16(v1[2] * bflo(b[3]), v1[3] * bfhi(b[3]));
                    *(u32x4*)(O + r * 2048 + col0 + bj * HALF) = w; }
                asm volatile("" ::: "memory"); }
    }
};
struct EpiRes {
    static constexpr bool PERM = false, AFTER_DRAIN = false, HAS_MID = false;
    const float* base; float* out; const float* g;
    __device__ __forceinline__ void operator()(const f32x4 (&acc)[2][2][4][2], const Unit& u, int wr, int wc, int fr, int fq) const {
        const int row0 = u.pm * BM + wr * 64 + fr, col0 = u.pn * BM + wc * 32 + 4 * fq;
        const float* gb = g + (size_t)(u.pm >> 3) * 12288 + col0;
        f32x4 gv[2][2];
#pragma unroll
        for (int bj = 0; bj < 2; ++bj)
#pragma unroll
            for (int n = 0; n < 2; ++n) gv[bj][n] = *(const f32x4*)(gb + bj * HALF + n * 16);
#pragma unroll
        for (int ai = 0; ai < 2; ++ai)
#pragma unroll
            for (int m = 0; m < 4; ++m) { const size_t off = (size_t)(row0 + ai * HALF + m * 16) * 2048 + col0;
#pragma unroll
                for (int bj = 0; bj < 2; ++bj)
#pragma unroll
                    for (int n = 0; n < 2; ++n) { const f32x4 bs = *(const f32x4*)(base + off + bj * HALF + n * 16);
                        *(f32x4*)(out + off + bj * HALF + n * 16) = bs + gv[bj][n] * acc[ai][bj][m][n]; } }
    }
};
template <typename TB> struct EpiResB {
    static constexpr bool PERM = true, AFTER_DRAIN = false, HAS_MID = false;
    const TB* base; bf16_t* out; const float* g;
    __device__ __forceinline__ void operator()(const f32x4 (&acc)[2][2][4][2], const Unit& u, int wr, int wc, int fr, int fq) const {
        const int row0 = u.pm * BM + wr * 64 + fr, col0 = u.pn * BM + wc * 32 + 8 * fq;
        const float* gb = g + (size_t)(u.pm >> 3) * 12288 + col0;
        f32x4 gv[2][2];
#pragma unroll
        for (int bj = 0; bj < 2; ++bj)
#pragma unroll
            for (int n = 0; n < 2; ++n) gv[bj][n] = *(const f32x4*)(gb + bj * HALF + n * 4);
#pragma unroll
        for (int ai = 0; ai < 2; ++ai)
#pragma unroll
            for (int m = 0; m < 4; ++m) { const size_t off = (size_t)(row0 + ai * HALF + m * 16) * 2048 + col0;
#pragma unroll
                for (int bj = 0; bj < 2; ++bj) { f32x4 b0, b1;
                    if constexpr (sizeof(TB) == 4) { b0 = __builtin_nontemporal_load((const f32x4*)((const float*)base + off + bj * HALF)); b1 = __builtin_nontemporal_load((const f32x4*)((const float*)base + off + bj * HALF + 4)); }
                    else { const u32x4 t = *(const u32x4*)((const bf16_t*)base + off + bj * HALF);
                        b0[0] = bflo(t[0]); b0[1] = bfhi(t[0]); b0[2] = bflo(t[1]); b0[3] = bfhi(t[1]); b1[0] = bflo(t[2]); b1[1] = bfhi(t[2]); b1[2] = bflo(t[3]); b1[3] = bfhi(t[3]); }
                    const f32x4 v0 = b0 + gv[bj][0] * acc[ai][bj][m][0], v1 = b1 + gv[bj][1] * acc[ai][bj][m][1];
                    u32x4 w; w.x = cvt_pk_bf16(v0[0], v0[1]); w.y = cvt_pk_bf16(v0[2], v0[3]); w.z = cvt_pk_bf16(v1[0], v1[1]); w.w = cvt_pk_bf16(v1[2], v1[3]);
                    *(u32x4*)(out + off + bj * HALF) = w; } }
    }
};
struct ProjOrder {
    StaticOrder so; int G, c;
    __device__ void init(int G_, int c_) { so.init(16384, 7168, G_, c_); G = G_; c = c_; }
    __device__ bool next(int i, Unit& u) const {
        const long L = (long)i * G + c;
        if (L < 1792) { Unit t; so.next(i, t); u.pm = (t.pm >> 3) * 9 + 1 + (t.pm & 7); u.pn = t.pn; return true; }
        if (L < 1832) { const int q = (int)(L - 1792); u.pm = (q / 5) * 9; u.pn = q % 5; return true; }
        return false;
    }
    __device__ __forceinline__ void a_ready(const Unit&) const {}
    __device__ __forceinline__ void done(const Unit&) const {}
};
struct ListOrder {
    int first, n, rows, rowbase;
    __device__ bool next(int i, Unit& u) const { if (i >= n) return false; const int q = first + i; u.pm = rowbase + q % rows; u.pn = q / rows; return true; }
    __device__ __forceinline__ void a_ready(const Unit&) const {}
    __device__ __forceinline__ void done(const Unit&) const {}
};
}
namespace pg8 {
template <class Epi, class Sched, bool ALIGN_EPI = false, bool SP2 = false>
__device__ __forceinline__ void gemm_phase(PG8_LAS unsigned char* lds, const Gemm g, const Sched& S, const Epi& E) {
    int tid = threadIdx.x; asm volatile("" : "+v"(tid));
    const int wid = __builtin_amdgcn_readfirstlane(tid >> 6), lane = tid & 63, wr = wid >> 2, wc = wid & 3, fr = lane & 15, fq = lane >> 4;
    const int K = g.K, nt = K / BK;
    unsigned voffA[2], voffB[2];
#pragma unroll
    for (int i = 0; i < 2; ++i) { int R, C; stage_rc(tid * 16 + i * 8192, R, C); const int Rb = Epi::PERM ? ((R & ~31) + perm32(R & 31)) : R;
        voffA[i] = (unsigned)(R * K + C) * 2u; voffB[i] = (unsigned)(Rb * K + C) * 2u; }
    const size_t kstep = (size_t)(BK * 2);
    const size_t hstep = (size_t)HALF * K * 2;
    const size_t tstep = 2 * hstep;
    const unsigned ldsw = (unsigned)wid * 1024u;
    const int aoff = lds_byte(wr * 64 + fr, fq * 8), boff = lds_byte(wc * 32 + fr, fq * 8);
#define PG8_SA(b, h) (((b) * 2 + (h)) * HTB)
#define PG8_SB(b, h) ((4 + (b) * 2 + (h)) * HTB)
#define PG8_STAGE(bufoff, gbase, voff) do { _Pragma("unroll") for (int _i = 0; _i < 2; ++_i) \
        __builtin_amdgcn_global_load_lds((const unsigned*)((const char*)(gbase) + (voff)[_i]), (PG8_LAS unsigned*)(lds + (bufoff) + ldsw + _i * 8192), 16, 0, 0); } while (0)
#define PG8_LDA(dst, b, h) do { _Pragma("unroll") for (int m = 0; m < 4; ++m) _Pragma("unroll") for (int k = 0; k < 2; ++k) dst[m][k] = *(const PG8_LAS bf16x8*)(lds + PG8_SA(b, h) + aoff + m * 2048 + k * 1024); } while (0)
#define PG8_LDB(dst, b, h) do { _Pragma("unroll") for (int n = 0; n < 2; ++n) _Pragma("unroll") for (int k = 0; k < 2; ++k) dst[n][k] = *(const PG8_LAS bf16x8*)(lds + PG8_SB(b, h) + boff + n * 2048 + k * 1024); } while (0)
#define PG8_MMA(ai, bj, At, Bt) do { __builtin_amdgcn_s_setprio(1); _Pragma("unroll") for (int m = 0; m < 4; ++m) _Pragma("unroll") for (int n = 0; n < 2; ++n) _Pragma("unroll") for (int k = 0; k < 2; ++k) \
        acc[ai][bj][m][n] = __builtin_amdgcn_mfma_f32_16x16x32_bf16(Bt[n][k], At[m][k], acc[ai][bj][m][n], 0, 0, 0); __builtin_amdgcn_s_setprio(0); } while (0)
#define PG8_WAIT_V(n) asm volatile("s_waitcnt vmcnt(" #n ")" ::: "memory")
#define PG8_WAIT_L(n) asm volatile("s_waitcnt lgkmcnt(" #n ")" ::: "memory")
#define PG8_BAR __builtin_amdgcn_s_barrier()
#define PG8_SCHED __builtin_amdgcn_sched_barrier(0)
    Unit cur, nxt; int ui = 0;
    if (!S.next(0, cur)) return;
    f32x4 acc[2][2][4][2];
#pragma unroll
    for (int a = 0; a < 2; ++a)
#pragma unroll
        for (int b = 0; b < 2; ++b)
#pragma unroll
            for (int m = 0; m < 4; ++m)
#pragma unroll
                for (int n = 0; n < 2; ++n) acc[a][b][m][n] = (f32x4){0.f, 0.f, 0.f, 0.f};
    bf16x8 At[4][2], B0[2][2], B1[2][2];
    const char* cA = (const char*)g.A + (size_t)cur.pm * tstep; const char* cB = (const char*)g.Bt + (size_t)cur.pn * tstep;
    S.a_ready(cur);
    if constexpr (SP2) {
        PG8_STAGE(PG8_SB(0, 0), cB, voffB); PG8_STAGE(PG8_SB(0, 1), cB + hstep, voffB); PG8_STAGE(PG8_SA(0, 0), cA, voffA); PG8_STAGE(PG8_SA(0, 1), cA + hstep, voffA);
        if (wr == 1) PG8_BAR;
        PG8_WAIT_V(2); PG8_BAR;
        PG8_STAGE(PG8_SB(1, 0), cB + kstep, voffB); PG8_STAGE(PG8_SA(1, 0), cA + kstep, voffA); PG8_STAGE(PG8_SB(1, 1), cB + hstep + kstep, voffB);
        PG8_WAIT_V(6); PG8_BAR;
    } else {
        PG8_STAGE(PG8_SB(0, 0), cB, voffB); PG8_STAGE(PG8_SA(0, 0), cA, voffA); PG8_STAGE(PG8_SB(0, 1), cB + hstep, voffB); PG8_STAGE(PG8_SA(0, 1), cA + hstep, voffA);
        if (wr == 1) PG8_BAR;
        PG8_WAIT_V(4); PG8_BAR;
        PG8_STAGE(PG8_SB(1, 0), cB + kstep, voffB); PG8_STAGE(PG8_SA(1, 0), cA + kstep, voffA); PG8_STAGE(PG8_SB(1, 1), cB + hstep + kstep, voffB);
        PG8_WAIT_V(6); PG8_BAR;
    }
    for (;;) {
        const bool has_next = S.next(ui + 1, nxt);
        const char* nA = has_next ? (const char*)g.A + (size_t)nxt.pm * tstep : cA; const char* nB = has_next ? (const char*)g.Bt + (size_t)nxt.pn * tstep : cB;
        constexpr int NSEG = Epi::HAS_MID ? 2 : 1; const int tseg = nt / NSEG;
#pragma unroll
        for (int seg = 0; seg < NSEG; ++seg) {
        if constexpr (Epi::HAS_MID) { if (seg == 1) E.mid(acc, cur, wr, wc, fr, fq); }
        for (int t = seg * tseg; t < (seg + 1) * tseg; t += 2) {
            const bool last = (t == nt - 2);
            const char* a1 = cA + (size_t)(t + 1) * kstep;
            const char* a2 = last ? nA : cA + (size_t)(t + 2) * kstep; const char* b2 = last ? nB : cB + (size_t)(t + 2) * kstep;
            const char* a3 = a2 + kstep; const char* b3 = b2 + kstep;
            if (last && has_next) S.a_ready(nxt);
            if constexpr (SP2) {
            PG8_LDB(B0, 0, 0); PG8_LDB(B1, 0, 1); PG8_SCHED; PG8_LDA(At, 0, 0); PG8_STAGE(PG8_SA(1, 1), a1 + hstep, voffA);
            PG8_WAIT_V(8); PG8_WAIT_L(0); PG8_BAR; PG8_MMA(0, 0, At, B0); PG8_MMA(0, 1, At, B1); PG8_BAR; PG8_SCHED;
            PG8_LDA(At, 0, 1); PG8_STAGE(PG8_SB(0, 0), b2, voffB); PG8_STAGE(PG8_SB(0, 1), b2 + hstep, voffB); PG8_STAGE(PG8_SA(0, 0), a2, voffA);
            PG8_WAIT_V(8); PG8_WAIT_L(0); PG8_BAR; PG8_MMA(1, 0, At, B0); PG8_MMA(1, 1, At, B1); PG8_BAR; PG8_SCHED;
            PG8_LDB(B0, 1, 0); PG8_LDB(B1, 1, 1); PG8_SCHED; PG8_LDA(At, 1, 0); PG8_STAGE(PG8_SA(0, 1), a2 + hstep, voffA);
            PG8_WAIT_V(8); PG8_WAIT_L(0); PG8_BAR; PG8_MMA(0, 0, At, B0); PG8_MMA(0, 1, At, B1); PG8_BAR; PG8_SCHED;
            PG8_LDA(At, 1, 1); PG8_STAGE(PG8_SB(1, 0), b3, voffB); PG8_STAGE(PG8_SB(1, 1), b3 + hstep, voffB); PG8_STAGE(PG8_SA(1, 0), a3, voffA);
            PG8_WAIT_V(8); PG8_WAIT_L(0); PG8_BAR; PG8_MMA(1, 0, At, B0); PG8_MMA(1, 1, At, B1); PG8_BAR; PG8_SCHED;
            } else {
            PG8_LDB(B0, 0, 0); PG8_SCHED; PG8_LDA(At, 0, 0); PG8_STAGE(PG8_SA(1, 1), a1 + hstep, voffA);
            PG8_WAIT_L(8); PG8_BAR; PG8_WAIT_L(0); PG8_MMA(0, 0, At, B0); PG8_BAR; PG8_SCHED;
            PG8_LDB(B1, 0, 1); PG8_STAGE(PG8_SB(0, 0), b2, voffB);
            PG8_BAR; PG8_WAIT_L(0); PG8_MMA(0, 1, At, B1); PG8_BAR;
            PG8_LDA(At, 0, 1); PG8_STAGE(PG8_SA(0, 0), a2, voffA);
            PG8_BAR; PG8_WAIT_L(0); PG8_MMA(1, 0, At, B0); PG8_BAR; PG8_SCHED;
            PG8_STAGE(PG8_SB(0, 1), b2 + hstep, voffB);
            PG8_WAIT_V(6); PG8_BAR; PG8_MMA(1, 1, At, B1); PG8_BAR;
            PG8_LDB(B0, 1, 0); PG8_SCHED; PG8_LDA(At, 1, 0); PG8_STAGE(PG8_SA(0, 1), a2 + hstep, voffA);
            PG8_WAIT_L(8); PG8_BAR; PG8_WAIT_L(0); PG8_MMA(0, 0, At, B0); PG8_BAR; PG8_SCHED;
            PG8_LDB(B1, 1, 1); PG8_STAGE(PG8_SB(1, 0), b3, voffB);
            PG8_BAR; PG8_WAIT_L(0); PG8_MMA(0, 1, At, B1); PG8_BAR;
            PG8_LDA(At, 1, 1); PG8_STAGE(PG8_SA(1, 0), a3, voffA);
            PG8_BAR; PG8_WAIT_L(0); PG8_MMA(1, 0, At, B0); PG8_BAR; PG8_SCHED;
            PG8_STAGE(PG8_SB(1, 1), b3 + hstep, voffB);
            PG8_WAIT_V(6); PG8_BAR; PG8_MMA(1, 1, At, B1); PG8_BAR;
            }
        }
        }
        if constexpr (ALIGN_EPI) { if (wr == 0) PG8_BAR; }
        if constexpr (!Epi::AFTER_DRAIN) { E(acc, cur, wr, wc, fr, fq); S.done(cur); }
        if (!has_next) break;
#pragma unroll
        for (int a = 0; a < 2; ++a)
#pragma unroll
            for (int b = 0; b < 2; ++b)
#pragma unroll
                for (int m = 0; m < 4; ++m)
#pragma unroll
                    for (int n = 0; n < 2; ++n) acc[a][b][m][n] = (f32x4){0.f, 0.f, 0.f, 0.f};
        cur = nxt; cA = nA; cB = nB; ++ui;
        if constexpr (ALIGN_EPI) { if (wr == 1) PG8_BAR; }
    }
    PG8_WAIT_V(0);
    if constexpr (!ALIGN_EPI) { if (wr == 0) PG8_BAR; }
    PG8_BAR;
    if constexpr (Epi::AFTER_DRAIN) { E.fused(acc, cur, wr, wc, fr, fq, lds, wid, lane); S.done(cur); }
#undef PG8_SA
#undef PG8_SB
#undef PG8_STAGE
#undef PG8_LDA
#undef PG8_LDB
#undef PG8_MMA
#undef PG8_WAIT_V
#undef PG8_WAIT_L
#undef PG8_BAR
#undef PG8_SCHED
}
}

namespace att {
using bf16_t = unsigned short;
using bf16x8 = __attribute__((ext_vector_type(8))) short;
using s16x4  = __attribute__((ext_vector_type(4))) short;
using f32x16 = __attribute__((ext_vector_type(16))) float;
using u32x4  = __attribute__((ext_vector_type(4))) unsigned;
constexpr int D = 128, NW = 8, QBLK = 32, KVBLK = 64;
#ifndef NQL
#define NQL 5
#endif
#ifndef NQL0
#define NQL0 0
#endif
#ifndef MLA_SD
#define MLA_SD 1
#endif
constexpr float THR = 8.f;
constexpr int SHM_V = KVBLK * D * 2, SHM_K = KVBLK * D * 2, SHM_KR = KVBLK * 64 * 2;
constexpr int OFF_V = 0, OFF_K = 2 * SHM_V, OFF_WS = OFF_K + 2 * SHM_K, OFF_KR = OFF_WS + NW * 64 * 4, OFF_QR = OFF_KR + 2 * SHM_KR, QRW = (4 + NQL) * 1024, LDS_BYTES = OFF_QR + NW * QRW;
#define KSWZ(row, colB) ((row) * 256 + ((colB) ^ (((row) & 15) << 4)))
#define KRSWZ(row, colB) ((row) * 128 + ((colB) ^ ((((row) >> 1) & 7) << 4)))
#define SBAR() __builtin_amdgcn_sched_barrier(0)
__device__ __forceinline__ int crow(int r, int hi) { return (r & 3) + 8 * (r >> 2) + 4 * hi; }
__device__ __forceinline__ unsigned cvtpk(float lo, float hi) { unsigned r; asm volatile("v_cvt_pk_bf16_f32 %0, %1, %2" : "=v"(r) : "v"(lo), "v"(hi)); return r; }
__device__ __forceinline__ void partialSM(f32x16& p0, f32x16& p1, float& m_reg, float& mn, float& alpha, const float SCALE) {
  const float C = SCALE * 1.4426950408889634f;
  float pmax = p0[0];
#pragma unroll
  for (int r = 1; r < 16; ++r) pmax = fmaxf(pmax, p0[r]);
#pragma unroll
  for (int r = 0; r < 16; ++r) pmax = fmaxf(pmax, p1[r]);
  { auto rr = __builtin_amdgcn_permlane32_swap(__float_as_uint(pmax), __float_as_uint(pmax), false, false);
    pmax = fmaxf(__uint_as_float(rr[0]), __uint_as_float(rr[1])); }
  if (__builtin_expect(__all(pmax - m_reg <= THR / SCALE), 1)) { mn = m_reg; alpha = 1.f; }
  else { mn = fmaxf(m_reg, pmax); alpha = __builtin_amdgcn_exp2f((m_reg - mn) * C); m_reg = mn; }
  float mnC = -mn * C;
#pragma unroll
  for (int r = 0; r < 16; ++r) p0[r] = fmaf(p0[r], C, mnC);
#pragma unroll
  for (int r = 0; r < 16; ++r) p1[r] = fmaf(p1[r], C, mnC);
#pragma unroll
  for (int r = 0; r < 16; ++r) p0[r] = __builtin_amdgcn_exp2f(p0[r]);
}
__device__ __forceinline__ void finishSM(f32x16& p0, f32x16& p1, float alpha, float& l_reg, bf16x8& pa0, bf16x8& pa1, bf16x8& pa2, bf16x8& pa3) {
#pragma unroll
  for (int r = 0; r < 16; ++r) p1[r] = __builtin_amdgcn_exp2f(p1[r]);
  float ps = 0;
#pragma unroll
  for (int r = 0; r < 16; ++r) ps += p0[r];
#pragma unroll
  for (int r = 0; r < 16; ++r) ps += p1[r];
  { auto rr = __builtin_amdgcn_permlane32_swap(__float_as_uint(ps), __float_as_uint(ps), false, false);
    ps = __uint_as_float(rr[0]) + __uint_as_float(rr[1]); }
  l_reg = l_reg * alpha + ps;
#define PK4(P, BASE, OUT) do { unsigned a0 = cvtpk(P[BASE + 0], P[BASE + 1]), a1 = cvtpk(P[BASE + 2], P[BASE + 3]);   \
    unsigned b0 = cvtpk(P[BASE + 4], P[BASE + 5]), b1 = cvtpk(P[BASE + 6], P[BASE + 7]);                              \
    auto r0 = __builtin_amdgcn_permlane32_swap(a0, b0, false, false); auto r1 = __builtin_amdgcn_permlane32_swap(a1, b1, false, false); \
    u32x4 w = {r0[0], r1[0], r0[1], r1[1]}; OUT = *reinterpret_cast<bf16x8*>(&w); } while (0)
  PK4(p0, 0, pa0); PK4(p0, 8, pa1); PK4(p1, 0, pa2); PK4(p1, 8, pa3);
#undef PK4
}
template <int DKR, int NQ>
__device__ __forceinline__ void qkt(f32x16& p0, f32x16& p1, const char* Ks, const char* Krs, const char* Qrs, const bf16x8* qr, int r32, int hi, int lane) {
  p0 = f32x16{}; p1 = f32x16{};
#pragma unroll
  for (int d0 = 0; d0 < 8; ++d0) { int cb = (d0 * 16 + hi * 8) * 2;
    bf16x8 b0 = *reinterpret_cast<const bf16x8*>(Ks + KSWZ(r32, cb));
    bf16x8 b1 = *reinterpret_cast<const bf16x8*>(Ks + KSWZ(32 + r32, cb));
    bf16x8 qf;
    if (d0 >= 8 - NQ) qf = *reinterpret_cast<const bf16x8*>(Qrs + (d0 - (8 - NQ) + 4) * 1024 + lane * 16); else qf = qr[d0];
    p0 = __builtin_amdgcn_mfma_f32_32x32x16_bf16(b0, qf, p0, 0, 0, 0);
    p1 = __builtin_amdgcn_mfma_f32_32x32x16_bf16(b1, qf, p1, 0, 0, 0); }
  if constexpr (DKR > 0) {
    SBAR();
#pragma unroll
    for (int d0 = 0; d0 < DKR / 16; ++d0) { int cb = (d0 * 16 + hi * 8) * 2;
      bf16x8 b0 = *reinterpret_cast<const bf16x8*>(Krs + KRSWZ(r32, cb));
      bf16x8 b1 = *reinterpret_cast<const bf16x8*>(Krs + KRSWZ(32 + r32, cb));
      bf16x8 qf = *reinterpret_cast<const bf16x8*>(Qrs + d0 * 1024 + lane * 16);
      p0 = __builtin_amdgcn_mfma_f32_32x32x16_bf16(b0, qf, p0, 0, 0, 0);
      p1 = __builtin_amdgcn_mfma_f32_32x32x16_bf16(b1, qf, p1, 0, 0, 0); }
  }
}
__device__ __forceinline__ int v_st(int k, int c) { const int kk = (k & ~0xC) | ((k & 4) << 1) | ((k & 8) >> 1); return ((kk >> 3) * 4 + (c >> 5)) * 512 + ((kk & 7) * 32 + (c & 31)) * 2; }
__device__ __forceinline__ int v_rd_base(int lane) { return ((lane & 3) << 3) | (((lane >> 2) & 3) << 6) | (((lane >> 4) & 1) << 5) | (((lane >> 5) & 1) << 8); }
constexpr int v_rd_off(int d0, int ks, int half) { return d0 * 512 + ks * 4096 + half * 2048; }
template <int OFF> __device__ __forceinline__ s16x4 tr_read(int vb) {
  s16x4 r; asm volatile("ds_read_b64_tr_b16 %0, %1 offset:%2" : "=&v"(r) : "v"(vb), "i"(OFF) : "memory"); return r;
}
template <int D0> __device__ __forceinline__ void pv_one(f32x16& od, int vb, bf16x8 pa0, bf16x8 pa1, bf16x8 pa2, bf16x8 pa3) {
  const s16x4 l0 = tr_read<v_rd_off(D0, 0, 0)>(vb), h0 = tr_read<v_rd_off(D0, 0, 1)>(vb), l1 = tr_read<v_rd_off(D0, 1, 0)>(vb), h1 = tr_read<v_rd_off(D0, 1, 1)>(vb);
  const s16x4 l2 = tr_read<v_rd_off(D0, 2, 0)>(vb), h2 = tr_read<v_rd_off(D0, 2, 1)>(vb), l3 = tr_read<v_rd_off(D0, 3, 0)>(vb), h3 = tr_read<v_rd_off(D0, 3, 1)>(vb);
  asm volatile("s_waitcnt lgkmcnt(0)" ::: "memory"); SBAR();
#define PK(L, H) (bf16x8){L[0], L[1], L[2], L[3], H[0], H[1], H[2], H[3]}
  od = __builtin_amdgcn_mfma_f32_32x32x16_bf16(pa0, PK(l0, h0), od, 0, 0, 0);
  od = __builtin_amdgcn_mfma_f32_32x32x16_bf16(pa1, PK(l1, h1), od, 0, 0, 0);
  od = __builtin_amdgcn_mfma_f32_32x32x16_bf16(pa2, PK(l2, h2), od, 0, 0, 0);
  od = __builtin_amdgcn_mfma_f32_32x32x16_bf16(pa3, PK(l3, h3), od, 0, 0, 0);
#undef PK
}
__device__ __forceinline__ void pv_d0(f32x16* o, int vb, bf16x8 pa0, bf16x8 pa1, bf16x8 pa2, bf16x8 pa3) {
  pv_one<0>(o[0], vb, pa0, pa1, pa2, pa3); pv_one<1>(o[1], vb, pa0, pa1, pa2, pa3); pv_one<2>(o[2], vb, pa0, pa1, pa2, pa3); pv_one<3>(o[3], vb, pa0, pa1, pa2, pa3);
}
__device__ __forceinline__ void pv_sm(f32x16* o, int vb, bf16x8 pa0, bf16x8 pa1, bf16x8 pa2, bf16x8 pa3, f32x16& p0, f32x16& p1, float& m_reg, float& mn, float& alpha, const float SCALE) {
  const float C = SCALE * 1.4426950408889634f;
  pv_one<0>(o[0], vb, pa0, pa1, pa2, pa3);
  float pmax = p0[0];
#pragma unroll
  for (int r = 1; r < 16; ++r) pmax = fmaxf(pmax, p0[r]);
  pv_one<1>(o[1], vb, pa0, pa1, pa2, pa3);
#pragma unroll
  for (int r = 0; r < 16; ++r) pmax = fmaxf(pmax, p1[r]);
  { auto rr = __builtin_amdgcn_permlane32_swap(__float_as_uint(pmax), __float_as_uint(pmax), false, false);
    pmax = fmaxf(__uint_as_float(rr[0]), __uint_as_float(rr[1])); }
  if (__builtin_expect(__all(pmax - m_reg <= THR / SCALE), 1)) { mn = m_reg; alpha = 1.f; }
  else { mn = fmaxf(m_reg, pmax); alpha = __builtin_amdgcn_exp2f((m_reg - mn) * C); m_reg = mn; }
  const float mnC = -mn * C;
  pv_one<2>(o[2], vb, pa0, pa1, pa2, pa3);
#pragma unroll
  for (int r = 0; r < 16; ++r) p0[r] = fmaf(p0[r], C, mnC);
#pragma unroll
  for (int r = 0; r < 16; ++r) p1[r] = fmaf(p1[r], C, mnC);
  pv_one<3>(o[3], vb, pa0, pa1, pa2, pa3);
#pragma unroll
  for (int r = 0; r < 16; ++r) p0[r] = __builtin_amdgcn_exp2f(p0[r]);
}
template <int DKR, int LDQ, int LDK, int LDV, int LDO>
__device__ __forceinline__ void attn_unit(const bf16_t* __restrict__ Qb, const bf16_t* __restrict__ Kh, const bf16_t* __restrict__ Kr, const bf16_t* __restrict__ Vh,
                                          bf16_t* __restrict__ Ob, int seq, char* lds, int qpos0, const float* __restrict__ rtab64) {
  constexpr float SCALE = DKR ? 0.07216878364870322f : 0.08838834764831845f;
  int tid = threadIdx.x; asm volatile("" : "+v"(tid));
  const int wid = tid >> 6, lane = tid & 63, r32 = lane & 31, hi = lane >> 5;
  char* V_lds = lds + OFF_V; char* K_lds = lds + OFF_K; char* KR_lds = lds + OFF_KR; char* QR_lds = lds + OFF_QR + wid * QRW;
  float* ws = (float*)(lds + OFF_WS) + wid * 64; float* li_l = ws; float* al_l = ws + 32;
  float m_reg = -1e30f, l_reg = 0; f32x16 o[4] = {}; constexpr int NQ = DKR ? NQL : NQL0; bf16x8 qr[8 - NQ];
  const bf16_t* Qw = Qb + (long)(wid * QBLK + r32) * LDQ + hi * 8;
#pragma unroll
  for (int d0 = 0; d0 < 8 - NQ; ++d0) qr[d0] = *reinterpret_cast<const bf16x8*>(Qw + d0 * 16);
#pragma unroll
  for (int d0 = 8 - NQ; d0 < 8; ++d0) *reinterpret_cast<bf16x8*>(QR_lds + (d0 - (8 - NQ) + 4) * 1024 + lane * 16) = *reinterpret_cast<const bf16x8*>(Qw + d0 * 16);
  if constexpr (DKR > 0) {
    bf16x8 qf[4];
#pragma unroll
    for (int d0 = 0; d0 < 4; ++d0) qf[d0] = *reinterpret_cast<const bf16x8*>(Qw + 128 + d0 * 16);
    const int tpos = qpos0 + wid * QBLK + r32;
#pragma unroll
    for (int ax = 0; ax < 2; ++ax) { const int ipos = ax ? (tpos & 63) : (tpos >> 6);
#pragma unroll
      for (int e = 0; e < 8; e += 2) { float o1[2], o2[2];
        const float4 cst = *reinterpret_cast<const float4*>(rtab64 + (ipos * 16 + 8 * hi + e) * 2);
#pragma unroll
        for (int k = 0; k < 2; ++k) { const float cs = k ? cst.z : cst.x, sn = k ? cst.w : cst.y;
          const float x1 = __uint_as_float(((unsigned)(unsigned short)qf[2 * ax][e + k]) << 16), x2 = __uint_as_float(((unsigned)(unsigned short)qf[2 * ax + 1][e + k]) << 16);
          o1[k] = x1 * cs - x2 * sn; o2[k] = x1 * sn + x2 * cs; }
        const unsigned w1 = cvtpk(o1[0], o1[1]), w2 = cvtpk(o2[0], o2[1]);
        qf[2 * ax][e] = (short)(w1 & 0xffffu); qf[2 * ax][e + 1] = (short)(w1 >> 16); qf[2 * ax + 1][e] = (short)(w2 & 0xffffu); qf[2 * ax + 1][e + 1] = (short)(w2 >> 16); } }
#pragma unroll
    for (int d0 = 0; d0 < 4; ++d0) *reinterpret_cast<bf16x8*>(QR_lds + d0 * 1024 + lane * 16) = qf[d0];
  }
  const int sr = tid >> 4, sc = (tid & 15) * 8, vst0 = v_st(sr, sc), vst1 = v_st(32 + sr, sc);
  const int krr = tid >> 3, krc = (tid & 7) * 8;
  const int vb0 = (int)(uintptr_t)V_lds + v_rd_base(lane);
  constexpr int SD = DKR ? MLA_SD : 2;
  struct { bf16x8 vs0, vs1, ks0, ks1, kr; } sr_[SD];
#define SLOAD(i, k0) do { sr_[i].vs0 = *reinterpret_cast<const bf16x8*>(&Vh[(long)((k0) + sr) * LDV + sc]); sr_[i].vs1 = *reinterpret_cast<const bf16x8*>(&Vh[(long)((k0) + 32 + sr) * LDV + sc]); \
    sr_[i].ks0 = *reinterpret_cast<const bf16x8*>(&Kh[(long)((k0) + sr) * LDK + sc]); sr_[i].ks1 = *reinterpret_cast<const bf16x8*>(&Kh[(long)((k0) + 32 + sr) * LDK + sc]); \
    if constexpr (DKR > 0) sr_[i].kr = *reinterpret_cast<const bf16x8*>(&Kr[(long)((k0) + krr) * 64 + krc]); } while (0)
#define SWRITE(b, i) do { *(bf16x8*)(V_lds + (b) * SHM_V + vst0) = sr_[i].vs0;          \
    *(bf16x8*)(V_lds + (b) * SHM_V + vst1) = sr_[i].vs1; int kc = sc * 2;               \
    *(bf16x8*)(K_lds + (b) * SHM_K + KSWZ(sr, kc)) = sr_[i].ks0;                       \
    *(bf16x8*)(K_lds + (b) * SHM_K + KSWZ(32 + sr, kc)) = sr_[i].ks1;                  \
    if constexpr (DKR > 0) *(bf16x8*)(KR_lds + (b) * SHM_KR + KRSWZ(krr, krc * 2)) = sr_[i].kr; } while (0)
#define SWAIT() do { if constexpr (SD == 1) asm volatile("s_waitcnt vmcnt(0)" ::: "memory"); else asm volatile("s_waitcnt vmcnt(4)" ::: "memory"); } while (0)
#define RESC(a) do { if (__any((a) < 1.f)) { if (hi == 0) al_l[r32] = (a); asm volatile("s_waitcnt lgkmcnt(0)" ::: "memory"); \
    _Pragma("unroll") for (int d = 0; d < 4; ++d) _Pragma("unroll") for (int r = 0; r < 16; ++r) o[d][r] *= al_l[crow(r, hi)]; } } while (0)
  f32x16 pA0, pA1, pB0, pB1; float mnA, mnB, alA, alB; bf16x8 pa0, pa1, pa2, pa3; const int NT = seq / KVBLK;
  constexpr int SE = 0, SO = SD - 1;
  SLOAD(SE, 0); asm volatile("s_waitcnt vmcnt(0)" ::: "memory"); SWRITE(0, SE); __syncthreads();
  qkt<DKR, NQ>(pA0, pA1, K_lds, KR_lds, QR_lds, qr, r32, hi, lane); partialSM(pA0, pA1, m_reg, mnA, alA, SCALE);
  SLOAD(SO, KVBLK); if constexpr (SD == 2) { if (2 < NT) SLOAD(SE, 2 * KVBLK); }
  SWAIT(); SWRITE(1, SO); __syncthreads();
  for (int j = 1; j + 1 < NT; j += 2) {
    SBAR(); qkt<DKR, NQ>(pB0, pB1, K_lds + SHM_K, KR_lds + SHM_KR, QR_lds, qr, r32, hi, lane);
    finishSM(pA0, pA1, alA, l_reg, pa0, pa1, pa2, pa3); SBAR();
    SLOAD(SO, (j + SD) * KVBLK); SBAR();
    pv_sm(o, vb0, pa0, pa1, pa2, pa3, pB0, pB1, m_reg, mnB, alB, SCALE);
    __syncthreads(); SWAIT(); SWRITE(0, SE);
    RESC(alB); __syncthreads();
    SBAR(); qkt<DKR, NQ>(pA0, pA1, K_lds, KR_lds, QR_lds, qr, r32, hi, lane);
    finishSM(pB0, pB1, alB, l_reg, pa0, pa1, pa2, pa3); SBAR();
    if (SD == 1 || j + 3 < NT) SLOAD(SE, (j + 1 + SD) * KVBLK); SBAR();
    pv_sm(o, vb0 + (int)SHM_V, pa0, pa1, pa2, pa3, pA0, pA1, m_reg, mnA, alA, SCALE);
    __syncthreads(); SWAIT(); SWRITE(1, SO);
    RESC(alA); __syncthreads();
  }
  SBAR(); qkt<DKR, NQ>(pB0, pB1, K_lds + SHM_K, KR_lds + SHM_KR, QR_lds, qr, r32, hi, lane);
  finishSM(pA0, pA1, alA, l_reg, pa0, pa1, pa2, pa3); SBAR();
  pv_sm(o, vb0, pa0, pa1, pa2, pa3, pB0, pB1, m_reg, mnB, alB, SCALE);
  __syncthreads(); RESC(alB);
  finishSM(pB0, pB1, alB, l_reg, pa0, pa1, pa2, pa3); SBAR();
  pv_d0(o, vb0 + (int)SHM_V, pa0, pa1, pa2, pa3);
  if (hi == 0) li_l[r32] = l_reg; asm volatile("s_waitcnt lgkmcnt(0)" ::: "memory");
  float rli[16];
#pragma unroll
  for (int r = 0; r < 16; ++r) rli[r] = __builtin_amdgcn_rcpf(li_l[crow(r, hi)]);
  bf16_t* Ow = Ob + (long)(wid * QBLK) * LDO;
#pragma unroll
  for (int r = 0; r < 16; ++r) { int orow = crow(r, hi);
#pragma unroll
    for (int d0 = 0; d0 < 4; ++d0) Ow[(long)orow * LDO + d0 * 32 + r32] = (bf16_t)(cvtpk(o[d0][r] * rli[r], 0.f) & 0xffffu); }
  __syncthreads();
#undef SLOAD
#undef SWRITE
#undef SWAIT
#undef RESC
}
#undef SBAR
}
typedef pg8::bf16_t bf16_t;
typedef float f32x4 __attribute__((ext_vector_type(4)));
typedef unsigned v4u __attribute__((ext_vector_type(4)));
typedef unsigned v2u __attribute__((ext_vector_type(2)));
#define LAS __attribute__((address_space(3)))
constexpr int NWAVES = 8, NTHR = 512;
constexpr int DM = 2048, NB = 8, SEQ = 2048, CTX = 256, TK = SEQ + CTX  , MLAT = NB * SEQ  , MZ = NB * TK  ;
constexpr int DFF = 5632, NUP = 2 * DFF, NIN = 7168;
constexpr float EPS = 1e-6f;
constexpr size_t MiB = 1u << 20;
constexpr size_t WS_MODP = 0;
constexpr size_t WS_MOD  = 7 * MiB;
constexpr size_t WS_RT64 = 7 * MiB + 440 * 1024, WS_RT128 = WS_RT64 + 8192;
constexpr size_t WS_CTL  = 7 * MiB + 512 * 1024, CTL_BYTES = 16384;
constexpr size_t WS_WUP  = 8 * MiB;
constexpr size_t WS_WDN  = 52 * MiB;
constexpr size_t WS_Z    = 74 * MiB;
constexpr size_t WS_KA   = WS_Z, WS_VA = WS_Z + 36 * MiB, WS_MRG = WS_Z, WS_Z2 = WS_Z;
constexpr size_t WS_WIN  = 146 * MiB;
constexpr size_t WS_WKV  = 174 * MiB;
constexpr size_t WS_WQ   = 176 * MiB;
constexpr size_t WS_WBR  = 179 * MiB;
constexpr size_t WS_WOUT = 187 * MiB;
constexpr size_t WS_ACT  = 195 * MiB;
constexpr size_t WS_CKV  = WS_ACT;
constexpr size_t WS_CQ   = WS_ACT + 18 * MiB;
constexpr size_t WS_OA   = WS_ACT, WS_OB = WS_ACT + 32 * MiB;
constexpr size_t WS_KB   = WS_ACT + 64 * MiB;
constexpr size_t WS_VB   = WS_KB + 9 * MiB;
constexpr size_t WS_KPE  = WS_VB + 9 * MiB;
constexpr size_t WS_QB   = WS_KPE + 3 * MiB;
constexpr size_t WS_GATE = WS_QB + 32 * MiB;
constexpr size_t WS_QA   = WS_GATE + 128 * MiB;
constexpr size_t WS_ATT_END = WS_QA + 48 * MiB;
constexpr size_t WS_X1B = WS_ACT, WS_X2B = WS_Z;
constexpr size_t WS_PART = 146 * MiB, WS_RAWB = 152 * MiB;
constexpr size_t WS_H    = 322 * MiB;
constexpr size_t WS_END  = 498 * MiB;
static_assert(WS_ATT_END <= WS_END && WS_RAWB + 6 * MiB <= WS_H, "ws map");
constexpr int EX_OFF = 131072;
constexpr int MISC_OFF = 157696; constexpr int LDS_BYTES = 157696 + 256; static_assert(att::LDS_BYTES <= LDS_BYTES, "attention LDS");

#define XB_TMO      128
#define XB_XCNT(j)  (256  + 64 * (j))
#define XB_XSUB(j)  (1280 + 64 * (j))
#define XB_XGEN(j)  (2304 + 64 * (j))
#define XB_TOP      3328
#define XB_TOPGEN   3392
#define XCD_BAR_WORDS 3456
#define XB_SPIN_CAP (1u << 18)

__device__ __forceinline__ unsigned xb_ld(unsigned* p)              { return __hip_atomic_load(p, __ATOMIC_RELAXED, __HIP_MEMORY_SCOPE_AGENT); }
__device__ __forceinline__ unsigned xb_add(unsigned* p, unsigned v) { return __hip_atomic_fetch_add(p, v, __ATOMIC_RELAXED, __HIP_MEMORY_SCOPE_AGENT); }
__device__ __forceinline__ unsigned xb_xcc_id() { return (unsigned)__builtin_amdgcn_s_getreg((3 << 11) | 20) & 0xFu; }
#define XB_SPIN(cond, bar) do { unsigned _sp = 0; while (cond) { __builtin_amdgcn_s_sleep(1); \
    if ((++_sp & 255u) == 0u) { if (xb_ld(&(bar)[XB_TMO])) break; if (_sp > XB_SPIN_CAP) { atomicAdd(&(bar)[XB_TMO], 1u); break; } } } } while (0)

struct XcdBarrier {
    unsigned* bar; unsigned x;
    volatile LAS unsigned* st;
};

__device__ __forceinline__ XcdBarrier xcd_barrier_post(unsigned* bar, volatile LAS unsigned* st) {
    XcdBarrier b; b.bar = bar; b.x = xb_xcc_id(); b.st = st;
    if (threadIdx.x == 0) (void)xb_add(&bar[XB_XCNT(b.x)], 1u);
    return b;
}
__device__ __forceinline__ void xcd_barrier_complete(unsigned* bar, unsigned x, unsigned& nloc, unsigned& nx) {
    const unsigned G = gridDim.x * gridDim.y * gridDim.z;
    unsigned sum, cnt, mine, sp = 0u;
    for (;;) {
        sum = 0u; cnt = 0u; mine = 0u;
#pragma unroll
        for (unsigned j = 0; j < 16; ++j) { const unsigned c = xb_ld(&bar[XB_XCNT(j)]); sum += c; cnt += (c > 0u) ? 1u : 0u; mine = (j == x) ? c : mine; }
        if (sum == G) break;
        __builtin_amdgcn_s_sleep(1);
        if ((++sp & 255u) == 0u) { if (xb_ld(&bar[XB_TMO])) break; if (sp > XB_SPIN_CAP) { atomicAdd(&bar[XB_TMO], 1u); break; } }
    }
    nloc = mine > 0u ? mine : 1u; nx = cnt > 0u ? cnt : 1u;
}

__device__ __forceinline__ void xcd_barrier(const XcdBarrier& b) {
    asm volatile("s_waitcnt vmcnt(0)" ::: "memory");
    __syncthreads();
    if (threadIdx.x == 0) {
        unsigned* bar = b.bar;
        __builtin_amdgcn_s_waitcnt(0);
        unsigned nloc = b.st[0], nx = b.st[1];
        if (nloc == 0u) { xcd_barrier_complete(bar, b.x, nloc, nx); b.st[0] = nloc; b.st[1] = nx; }
        const unsigned old = xb_add(&bar[XB_XSUB(b.x)], 1u);
        const unsigned gen = old / nloc;
        if (old + 1u == (gen + 1u) * nloc) {
            __builtin_amdgcn_fence(__ATOMIC_RELEASE, "agent");
            asm volatile("s_waitcnt vmcnt(0)" ::: "memory");
            const unsigned og = xb_add(&bar[XB_TOP], 1u);
            const unsigned tg = og / nx;
            if (og + 1u == (tg + 1u) * nx) xb_add(&bar[XB_TOPGEN], 1u);
            else XB_SPIN(xb_ld(&bar[XB_TOPGEN]) == tg, bar);
            __builtin_amdgcn_fence(__ATOMIC_ACQUIRE, "agent");
            xb_add(&bar[XB_XGEN(b.x)], 1u);
            asm volatile("s_waitcnt vmcnt(0)" ::: "memory");
        } else {
            XB_SPIN(xb_ld(&bar[XB_XGEN(b.x)]) == gen, bar);
            __builtin_amdgcn_fence(__ATOMIC_ACQUIRE, "agent");
            asm volatile("s_waitcnt vmcnt(0)" ::: "memory");
        }
    }
    __syncthreads();
}

struct Args {
    const float *x, *c, *ctx, *c_ctx, *w_ada, *b_ada, *norm1_g, *w_in, *mla_q_norm_g, *w_q_up, *mla_kv_norm_g, *w_kv_up, *gqa_q_norm_g, *gqa_k_norm_g,
                *w_br_a, *w_br_b, *w_out, *norm2_g, *w_up, *conv_w, *conv_b, *w_down, *final_norm_g;
    float* out; unsigned char* ws;
};
__device__ __forceinline__ unsigned f2bf(float f) { unsigned u = __builtin_bit_cast(unsigned, f); return (u + 0x7fffu + ((u >> 16) & 1u)) >> 16; }
__device__ __forceinline__ unsigned pk2(float lo, float hi) { return f2bf(lo) | (f2bf(hi) << 16); }
__device__ __forceinline__ float blo(unsigned w) { return __uint_as_float(w << 16); }
__device__ __forceinline__ float bhi(unsigned w) { return __uint_as_float(w & 0xffff0000u); }
__device__ __forceinline__ float wave_sum(float v) {
#pragma unroll
    for (int o = 1; o < 64; o <<= 1) v += __shfl_xor(v, o);
    return v;
}
__device__ __forceinline__ void transpose_item(const float* W, int N, bf16_t* WT, int Kdst, int koff, int k0, int n0, int drow0, const float* kscale, LAS float* scr, int lane) {
    float tv[32];
#pragma unroll
    for (int i = 0; i < 32; ++i) { const int kk = 2 * i + (lane >> 5); tv[i] = __builtin_nontemporal_load(W + (size_t)(k0 + kk) * N + n0 + (lane & 31)); }
#pragma unroll
    for (int i = 0; i < 32; ++i) { const int kk = 2 * i + (lane >> 5); float v = tv[i]; if (kscale) v *= kscale[k0 + kk]; scr[kk * 33 + (lane & 31)] = v; }
    asm volatile("s_waitcnt lgkmcnt(0)" ::: "memory");
    const int c = lane & 7;
#pragma unroll
    for (int j = 0; j < 4; ++j) { const int n = (lane >> 3) + 8 * j; const LAS float* s = scr + (8 * c) * 33 + n;
        v4u o; o.x = pk2(s[0 * 33], s[1 * 33]); o.y = pk2(s[2 * 33], s[3 * 33]); o.z = pk2(s[4 * 33], s[5 * 33]); o.w = pk2(s[6 * 33], s[7 * 33]);
        *(v4u*)(WT + (size_t)(drow0 + n) * Kdst + koff + k0 + 8 * c) = o; }
    asm volatile("s_waitcnt lgkmcnt(0)" ::: "memory");
}
__device__ __forceinline__ int win_map(int n0) {
    if (n0 < 512) return n0;
    if (n0 < 576) return 1024 + (n0 - 512);
    if (n0 < 832) return 512 + (n0 - 576);
    if (n0 < 1088) return 768 + (n0 - 832);
    if (n0 < 2880) return n0 + 192;
    { const int gi = n0 - 2880, half = gi >= 2048 ? 1 : 0, ch = gi - half * 2048; return 3072 + (ch >> 7) * 256 + half * 128 + (ch & 127); }
}
__device__ __forceinline__ int up_map(int n0) { const int ch = n0 < 5632 ? n0 : n0 - 5632; return (ch >> 7) * 256 + (n0 < 5632 ? 0 : 128) + (ch & 127); }
__device__ __forceinline__ void row_norm_mod(const float* xrow, bf16_t* orow, const float* g, const LAS float* SH, const LAS float* SC, int lane) {
    const f32x4* xr = (const f32x4*)xrow + lane; f32x4 v[8]; float s = 0.f;
#pragma unroll
    for (int j = 0; j < 8; ++j) { v[j] = __builtin_nontemporal_load(xr + 64 * j); s += (v[j].x * v[j].x + v[j].y * v[j].y) + (v[j].z * v[j].z + v[j].w * v[j].w); }
    const float rstd = 1.0f / sqrtf(wave_sum(s) * (1.f / 2048.f) + EPS);
    v2u* o8 = (v2u*)orow + lane;
#pragma unroll
    for (int j = 0; j < 8; ++j) { const int cidx = (lane + 64 * j) * 4; const f32x4 gg = *(const f32x4*)(g + cidx);
        const float a0 = (v[j].x * rstd * gg.x) * (1.f + SC[cidx]) + SH[cidx], a1 = (v[j].y * rstd * gg.y) * (1.f + SC[cidx + 1]) + SH[cidx + 1];
        const float a2 = (v[j].z * rstd * gg.z) * (1.f + SC[cidx + 2]) + SH[cidx + 2], a3 = (v[j].w * rstd * gg.w) * (1.f + SC[cidx + 3]) + SH[cidx + 3];
        v2u w; w.x = pk2(a0, a1); w.y = pk2(a2, a3); o8[64 * j] = w; }
}
__device__ __forceinline__ void row_norm_mod_bf(const bf16_t* xrow, bf16_t* orow, const float* g, const LAS float* SH, const LAS float* SC, int lane) {
    const v4u* xr = (const v4u*)xrow + lane; v4u w[4]; float s = 0.f;
#pragma unroll
    for (int j = 0; j < 4; ++j) { w[j] = xr[64 * j];
#pragma unroll
        for (int e = 0; e < 4; ++e) { const float a = blo(w[j][e]), c = bhi(w[j][e]); s += a * a + c * c; } }
    const float rstd = 1.0f / sqrtf(wave_sum(s) * (1.f / 2048.f) + EPS);
    v4u* o16 = (v4u*)orow + lane;
#pragma unroll
    for (int j = 0; j < 4; ++j) { const int cidx = (lane + 64 * j) * 8; v4u o;
#pragma unroll
        for (int e = 0; e < 4; ++e) { const int c0 = cidx + 2 * e;
            const float a0 = (blo(w[j][e]) * rstd * g[c0]) * (1.f + SC[c0]) + SH[c0], a1 = (bhi(w[j][e]) * rstd * g[c0 + 1]) * (1.f + SC[c0 + 1]) + SH[c0 + 1];
            o[e] = pk2(a0, a1); }
        o16[64 * j] = o; }
}
__device__ __forceinline__ void row_norm_mod_bf2(const bf16_t* xa, bf16_t* oa, const bf16_t* xb, bf16_t* ob, const float* g, const LAS float* SH, const LAS float* SC, int lane) {
    const v4u* pa = (const v4u*)xa + lane; const v4u* pb = (const v4u*)xb + lane; v4u wa[4], wb[4]; float sa = 0.f, sb = 0.f;
#pragma unroll
    for (int j = 0; j < 4; ++j) { wa[j] = pa[64 * j]; wb[j] = pb[64 * j]; }
#pragma unroll
    for (int j = 0; j < 4; ++j)
#pragma unroll
        for (int e = 0; e < 4; ++e) { const float a = blo(wa[j][e]), c = bhi(wa[j][e]), a2 = blo(wb[j][e]), c2 = bhi(wb[j][e]); sa += a * a + c * c; sb += a2 * a2 + c2 * c2; }
#pragma unroll
    for (int o = 1; o < 64; o <<= 1) { sa += __shfl_xor(sa, o); sb += __shfl_xor(sb, o); }
    const float ra = 1.0f / sqrtf(sa * (1.f / 2048.f) + EPS), rb = 1.0f / sqrtf(sb * (1.f / 2048.f) + EPS);
    v4u* qa = (v4u*)oa + lane; v4u* qb = (v4u*)ob + lane;
#pragma unroll
    for (int j = 0; j < 4; ++j) { const int cidx = (lane + 64 * j) * 8; v4u o0, o1;
#pragma unroll
        for (int e = 0; e < 4; ++e) { const int c0 = cidx + 2 * e; const float g0 = g[c0], g1 = g[c0 + 1], m0 = 1.f + SC[c0], m1 = 1.f + SC[c0 + 1], h0 = SH[c0], h1 = SH[c0 + 1];
            o0[e] = pk2((blo(wa[j][e]) * ra * g0) * m0 + h0, (bhi(wa[j][e]) * ra * g1) * m1 + h1);
            o1[e] = pk2((blo(wb[j][e]) * rb * g0) * m0 + h0, (bhi(wb[j][e]) * rb * g1) * m1 + h1); }
        qa[64 * j] = o0; qb[64 * j] = o1; }
}
struct Rope { float c0, s0, c1, s1; };
__device__ __forceinline__ Rope rope_setup(int w, int R, int grow, int gcol, const float* tab) {
    const int q = R / 4, d = 2 * w, axis = d / (2 * q), j = d & (q - 1);
    const int ipos = axis ? gcol : grow;
    const f32x4 cst = *(const f32x4*)(tab + (ipos * q + j) * 2);
    Rope r; r.c0 = cst[0]; r.s0 = cst[1]; r.c1 = cst[2]; r.s1 = cst[3];
    const bool x2 = (d & q) != 0; if (!x2) { r.s0 = -r.s0; r.s1 = -r.s1; }
    return r;
}
#ifndef REP0
#define REP0 1
#endif
#ifndef REP2
#define REP2 1
#endif
#ifndef REP6
#define REP6 1
#endif
__global__ void __launch_bounds__(NTHR, 2) fwd_megakernel(Args A) {
    extern __shared__ __attribute__((aligned(16))) unsigned char lds_raw[];
    cg::grid_group grid = cg::this_grid();
    LAS unsigned char* lds = (LAS unsigned char*)lds_raw;
    const int G = gridDim.x, blk = blockIdx.x, NGW = G * NWAVES;
    { volatile LAS unsigned* mz = (volatile LAS unsigned*)(lds + MISC_OFF); if (threadIdx.x < 64) mz[threadIdx.x] = 0u; }
    __syncthreads();
    grid.sync();
    const XcdBarrier bar = xcd_barrier_post((unsigned*)(A.ws + WS_CTL), (volatile LAS unsigned*)(lds + MISC_OFF) + 8);
#define PHASE_IDS int tid = threadIdx.x; asm volatile("" : "+v"(tid)); const int lane = tid & 63, wave = __builtin_amdgcn_readfirstlane(tid >> 6), gw = blk * NWAVES + wave; (void)lane; (void)gw;
    unsigned char* ws = A.ws;
    float* MODP = (float*)(ws + WS_MODP); float* MOD = (float*)(ws + WS_MOD); float* RT64 = (float*)(ws + WS_RT64); float* RT128 = (float*)(ws + WS_RT128);
    bf16_t* WUP = (bf16_t*)(ws + WS_WUP); bf16_t* WDN = (bf16_t*)(ws + WS_WDN); bf16_t* Z = (bf16_t*)(ws + WS_Z);
    bf16_t* WIN = (bf16_t*)(ws + WS_WIN); bf16_t* WKV = (bf16_t*)(ws + WS_WKV); bf16_t* WQ = (bf16_t*)(ws + WS_WQ); bf16_t* WBR = (bf16_t*)(ws + WS_WBR); bf16_t* WOUT = (bf16_t*)(ws + WS_WOUT);
    bf16_t* CKV = (bf16_t*)(ws + WS_CKV); bf16_t* CQ = (bf16_t*)(ws + WS_CQ); bf16_t* OA = (bf16_t*)(ws + WS_OA); bf16_t* OB = (bf16_t*)(ws + WS_OB); bf16_t* KBm = (bf16_t*)(ws + WS_KB); bf16_t* VBm = (bf16_t*)(ws + WS_VB);
    bf16_t* KPE = (bf16_t*)(ws + WS_KPE); bf16_t* QB = (bf16_t*)(ws + WS_QB); bf16_t* GATE = (bf16_t*)(ws + WS_GATE); bf16_t* QA = (bf16_t*)(ws + WS_QA);
    bf16_t* KA = (bf16_t*)(ws + WS_KA); bf16_t* VA = (bf16_t*)(ws + WS_VA); bf16_t* MRG = (bf16_t*)(ws + WS_MRG); bf16_t* Z2 = (bf16_t*)(ws + WS_Z2);
    bf16_t* X1B = (bf16_t*)(ws + WS_X1B); bf16_t* X2B = (bf16_t*)(ws + WS_X2B);
    float* PART = (float*)(ws + WS_PART); float* RAWB = (float*)(ws + WS_RAWB); bf16_t* H = (bf16_t*)(ws + WS_H);

#if !defined(ONLY) || ONLY==0
    _Pragma("unroll 1") for (int rep0 = 0; rep0 < REP0; ++rep0) {
        PHASE_IDS
        LAS float* S = (LAS float*)lds;
        LAS float* R = (LAS float*)(lds + 8192);
        for (int item = blk; item < 16 * 48; item += G) {
            const int kc = item / 48, nc = item % 48;
            for (int idx = tid; idx < 9 * 128; idx += NTHR) { const int cn = idx >> 7, k = kc * 128 + (idx & 127); const float v = cn < 8 ? A.c[cn * 2048 + k] : A.c_ctx[k]; S[idx] = v / (1.f + __expf(-v)); }
            __syncthreads();
            const int col4 = tid & 63, ks = tid >> 6;
            f32x4 acc[9];
#pragma unroll
            for (int cn = 0; cn < 9; ++cn) acc[cn] = (f32x4){0.f, 0.f, 0.f, 0.f};
            const f32x4* wp = (const f32x4*)(A.w_ada + (size_t)(kc * 128 + ks * 16) * 12288 + nc * 256) + col4;
#pragma unroll 4
            for (int kk = 0; kk < 16; ++kk) { const f32x4 w = __builtin_nontemporal_load(wp + (size_t)kk * 3072);
#pragma unroll
                for (int cn = 0; cn < 9; ++cn) acc[cn] += S[cn * 128 + ks * 16 + kk] * w; }
#pragma unroll
            for (int cn = 0; cn < 9; ++cn) ((LAS f32x4*)R)[(ks * 9 + cn) * 64 + col4] = acc[cn];
            __syncthreads();
            for (int o = tid; o < 9 * 256; o += NTHR) { const int cn = o >> 8, cc = o & 255; float s = 0.f;
#pragma unroll
                for (int k2 = 0; k2 < 8; ++k2) s += R[(k2 * 9 + cn) * 256 + cc];
                MODP[(size_t)(kc * 9 + cn) * 12288 + nc * 256 + cc] = s; }
            __syncthreads();
        }
        LAS float* scr = (LAS float*)(lds + wave * 16384);
        constexpr int I_IN = 32 * 218, I_KV = 8 * 64, I_Q = 12 * 48, I_BR = 16 * 64, I_OUT = 32 * 64, I_UP = 32 * 352, I_DN = 88 * 64;
        constexpr int NITEMS = I_IN + I_KV + I_Q;
        for (int it = gw; it < NITEMS; it += NGW) {
            int r = it;
            if (r < I_IN) { const int nb = r % 218, kb = r / 218; transpose_item(A.w_in, 6976, WIN, 2048, 0, kb * 64, nb * 32, win_map(nb * 32), nullptr, scr, lane); continue; } r -= I_IN;
            if (r < I_KV) { const int nb = r % 64, kb = r / 64; transpose_item(A.w_kv_up, 2048, WKV, 512, 0, kb * 64, nb * 32, nb * 32, A.mla_kv_norm_g, scr, lane); continue; } r -= I_KV;
            { const int nb = r % 48, kb = r / 48; transpose_item(A.w_q_up, 1536, WQ, 768, 0, kb * 64, nb * 32, nb * 32, A.mla_q_norm_g, scr, lane); }
        }
        for (int i = blk * NTHR + tid; i < 64 * 16 + 64 * 32; i += G * NTHR) {
            const bool big = i >= 64 * 16; const int k = big ? i - 64 * 16 : i, q = big ? 32 : 16, pos = k / q, j = k - pos * q;
            float sn, cs; sincosf((float)pos * exp2f(-(float)j * (13.287712379549449f / (float)q)), &sn, &cs);
            float* tp = (big ? RT128 : RT64) + (size_t)k * 2; tp[0] = cs; tp[1] = sn; }
        for (int i = blk * NTHR + tid; i < 192 * 2048 / 8; i += G * NTHR) *(v4u*)(WIN + (size_t)1088 * 2048 + (size_t)i * 8) = (v4u){0u, 0u, 0u, 0u};
        if (REP0 > 1) __syncthreads();
    }
#endif
    xcd_barrier(bar);

#if !defined(ONLY) || ONLY==1
    {
        PHASE_IDS
        LAS float* SH = (LAS float*)lds; LAS float* SC = SH + 2048;
        const bool is_ctx = blk >= 224; const int cn = is_ctx ? 8 : blk / 28, bi = is_ctx ? blk - 224 : blk % 28;
        {
            float sv8[8];
#pragma unroll
            for (int q = 0; q < 8; ++q) sv8[q] = A.b_ada[tid + q * NTHR];
#pragma unroll
            for (int kc = 0; kc < 16; ++kc)
#pragma unroll
                for (int q = 0; q < 8; ++q) sv8[q] += MODP[(size_t)(kc * 9 + cn) * 12288 + tid + q * NTHR];
#pragma unroll
            for (int q = 0; q < 8; ++q) SH[tid + q * NTHR] = sv8[q];
        }
        for (int idx = blk * 432 + tid; idx < (blk + 1) * 432; idx += NTHR) { const int c2 = idx / 12288, col = idx % 12288; float s = A.b_ada[col];
#pragma unroll
            for (int kc = 0; kc < 16; ++kc) s += MODP[(size_t)(kc * 9 + c2) * 12288 + col];
            MOD[idx] = s; }
        __syncthreads();
        if (!is_ctx) { for (int t = bi * 8 + wave; t < SEQ; t += 28 * 8) row_norm_mod(A.x + ((size_t)cn * SEQ + t) * DM, Z + ((size_t)cn * TK + CTX + t) * DM, A.norm1_g, SH, SC, lane); }
        else { for (int cr = bi * 8 + wave; cr < NB * CTX; cr += 32 * 8) { const int b = cr >> 8, j = cr & 255; row_norm_mod(A.ctx + (size_t)cr * DM, Z + ((size_t)b * TK + j) * DM, A.norm1_g, SH, SC, lane); } }
    }
#endif
    xcd_barrier(bar);

#if !defined(ONLY) || ONLY==2
    _Pragma("unroll 1") for (int rep2 = 0; rep2 < REP2; ++rep2) {
        pg8::Gemm g{Z, WIN, MZ, NIN, DM}; pg8::ProjOrder S; S.init(G, blk);
        pg8::EpiProj E{CKV, KBm, VBm, KPE, CQ, QB, GATE};
        pg8::gemm_phase<pg8::EpiProj, pg8::ProjOrder, true, true>(lds, g, S, E);
        const int nfull = 1832 - 7 * G;
        if (G == 256 && blk >= nfull) { PHASE_IDS
            LAS float* scr = (LAS float*)(lds + wave * 16384);
            constexpr int I_UP = 32 * 352, I_DN = 88 * 64;
            const int nw = (G - nfull) * NWAVES;
            for (int it = (blk - nfull) * NWAVES + wave; it < I_UP + I_DN + 4096; it += nw) {
                if (it < I_UP) { const int nb = it % 352, kb = it / 352; transpose_item(A.w_up, 11264, WUP, 2048, 0, kb * 64, nb * 32, up_map(nb * 32), nullptr, scr, lane); }
                else if (it < I_UP + I_DN) { const int r = it - I_UP; const int nb = r % 64, kb = r / 64; transpose_item(A.w_down, 2048, WDN, 5632, 0, kb * 64, nb * 32, nb * 32, nullptr, scr, lane); }
                else { int r = it - I_UP - I_DN; const int which = r / 1024; r -= which * 1024; const int nb = r % 64, kb = r / 64;
                    if (which == 0) transpose_item(A.w_br_a, 2048, WBR, 2048, 0, kb * 64, nb * 32, nb * 32, nullptr, scr, lane);
                    else if (which == 1) transpose_item(A.w_br_b, 2048, WBR, 2048, 1024, kb * 64, nb * 32, nb * 32, nullptr, scr, lane);
                    else transpose_item(A.w_out, 2048, WOUT, 2048, 0, (kb + (which - 2) * 16) * 64, nb * 32, nb * 32, nullptr, scr, lane); }
            }
        } else if (G != 256) { PHASE_IDS
            LAS float* scr = (LAS float*)(lds + wave * 16384);
            constexpr int I_UP = 32 * 352, I_DN = 88 * 64;
            for (int it = gw; it < I_UP + I_DN + 4096; it += NGW) {
                if (it < I_UP) { const int nb = it % 352, kb = it / 352; transpose_item(A.w_up, 11264, WUP, 2048, 0, kb * 64, nb * 32, up_map(nb * 32), nullptr, scr, lane); }
                else if (it < I_UP + I_DN) { const int r = it - I_UP; const int nb = r % 64, kb = r / 64; transpose_item(A.w_down, 2048, WDN, 5632, 0, kb * 64, nb * 32, nb * 32, nullptr, scr, lane); }
                else { int r = it - I_UP - I_DN; const int which = r / 1024; r -= which * 1024; const int nb = r % 64, kb = r / 64;
                    if (which == 0) transpose_item(A.w_br_a, 2048, WBR, 2048, 0, kb * 64, nb * 32, nb * 32, nullptr, scr, lane);
                    else if (which == 1) transpose_item(A.w_br_b, 2048, WBR, 2048, 1024, kb * 64, nb * 32, nb * 32, nullptr, scr, lane);
                    else transpose_item(A.w_out, 2048, WOUT, 2048, 0, (kb + (which - 2) * 16) * 64, nb * 32, nb * 32, nullptr, scr, lane); }
            }
        }
    }
#endif
    xcd_barrier(bar);

#if !defined(ONLY) || ONLY==3
    { PHASE_IDS
    const float gk0 = A.gqa_k_norm_g[2 * lane], gk1 = A.gqa_k_norm_g[2 * lane + 1], gq0 = A.gqa_q_norm_g[2 * lane], gq1 = A.gqa_q_norm_g[2 * lane + 1];
    for (int rz = gw; rz < MZ; rz += NGW) {
        const int b = rz / TK, j = rz - b * TK; const bool lat = j >= CTX; const int t = j - CTX, grow = t >> 6, gcol = t & 63;
        unsigned* pckv = (unsigned*)(CKV + (size_t)rz * 512) + lane; unsigned* pkb = (unsigned*)(KBm + (size_t)rz * 256) + lane; unsigned* pkpe = (unsigned*)(KPE + (size_t)rz * 64) + (lane & 31);
        const size_t rl = (size_t)b * SEQ + (lat ? t : 0);
        unsigned* pcq = (unsigned*)(CQ + rl * 768) + lane; unsigned* pqb = (unsigned*)(QB + rl * 1024) + lane;
        unsigned wckv[4], wkb[2], wkpe, wcq[6], wqb[8];
#pragma unroll
        for (int i = 0; i < 4; ++i) wckv[i] = pckv[64 * i];
#pragma unroll
        for (int hh = 0; hh < 2; ++hh) wkb[hh] = pkb[64 * hh];
        wkpe = *pkpe;
        if (lat) {
#pragma unroll
            for (int i = 0; i < 6; ++i) wcq[i] = pcq[64 * i];
#pragma unroll
            for (int hh = 0; hh < 8; ++hh) wqb[hh] = pqb[64 * hh];
        } else {
#pragma unroll
            for (int i = 0; i < 6; ++i) wcq[i] = 0u;
#pragma unroll
            for (int hh = 0; hh < 8; ++hh) wqb[hh] = 0u;
        }
        Rope r128 = {1.f, 0.f, 1.f, 0.f}, r64 = {1.f, 0.f, 1.f, 0.f};
        if (lat) { r128 = rope_setup(lane, 128, grow, gcol, RT128); r64 = rope_setup(lane & 31, 64, grow, gcol, RT64); }
        float sv[12];
        sv[0] = 0.f;
#pragma unroll
        for (int i = 0; i < 4; ++i) { const float a = blo(wckv[i]), c = bhi(wckv[i]); sv[0] += a * a + c * c; }
#pragma unroll
        for (int hh = 0; hh < 2; ++hh) { const float a = blo(wkb[hh]), c = bhi(wkb[hh]); sv[1 + hh] = a * a + c * c; }
        sv[3] = 0.f;
#pragma unroll
        for (int i = 0; i < 6; ++i) { const float a = blo(wcq[i]), c = bhi(wcq[i]); sv[3] += a * a + c * c; }
#pragma unroll
        for (int hh = 0; hh < 8; ++hh) { const float a = blo(wqb[hh]), c = bhi(wqb[hh]); sv[4 + hh] = a * a + c * c; }
#pragma unroll
        for (int o = 1; o < 64; o <<= 1) {
#pragma unroll
            for (int q = 0; q < 12; ++q) sv[q] += __shfl_xor(sv[q], o); }
        { const float rstd = 1.0f / sqrtf(sv[0] * (1.f / 512.f) + EPS);
#pragma unroll
            for (int i = 0; i < 4; ++i) pckv[64 * i] = pk2(blo(wckv[i]) * rstd, bhi(wckv[i]) * rstd); }
#pragma unroll
        for (int hh = 0; hh < 2; ++hh) { const float rstd = 1.0f / sqrtf(sv[1 + hh] * (1.f / 128.f) + EPS);
            const float a = blo(wkb[hh]) * rstd * gk0, c = bhi(wkb[hh]) * rstd * gk1; const float pa = __shfl_xor(a, 16), pc = __shfl_xor(c, 16);
            pkb[64 * hh] = pk2(a * r128.c0 + pa * r128.s0, c * r128.c1 + pc * r128.s1); }
        { const float a = blo(wkpe), c = bhi(wkpe); const float pa = __shfl_xor(a, 8), pc = __shfl_xor(c, 8);
            if (lat && lane < 32) *pkpe = pk2(a * r64.c0 + pa * r64.s0, c * r64.c1 + pc * r64.s1); }
        if (lat) {
            { const float rstd = 1.0f / sqrtf(sv[3] * (1.f / 768.f) + EPS);
#pragma unroll
                for (int i = 0; i < 6; ++i) pcq[64 * i] = pk2(blo(wcq[i]) * rstd, bhi(wcq[i]) * rstd); }
#pragma unroll
            for (int hh = 0; hh < 8; ++hh) { const float rstd = 1.0f / sqrtf(sv[4 + hh] * (1.f / 128.f) + EPS);
                const float a = blo(wqb[hh]) * rstd * gq0, c = bhi(wqb[hh]) * rstd * gq1; const float pa = __shfl_xor(a, 16), pc = __shfl_xor(c, 16);
                pqb[64 * hh] = pk2(a * r128.c0 + pa * r128.s0, c * r128.c1 + pc * r128.s1); }
        }
    }
    }
#endif
    xcd_barrier(bar);

#if !defined(ONLY) || ONLY==4
    {
        const int xc = blk & 7, jc = blk >> 3;
        { pg8::Gemm g{CQ, WQ, MLAT, 1536, 768}; pg8::ListOrder S{jc < 8 ? jc * 3 : 24 + (jc - 8), jc < 8 ? 3 : 1, 8, xc * 8};
          pg8::EpiPlain E{QA, 1536};
          pg8::gemm_phase<pg8::EpiPlain, pg8::ListOrder, true, true>(lds, g, S, E); }
        if (jc >= 8) { pg8::Gemm g{CKV, WKV, MZ, 2048, 512}; pg8::ListOrder S{(jc - 8) * 3, 3, 9, xc * 9};
          pg8::EpiKV E{KA, VA};
          pg8::gemm_phase<pg8::EpiKV, pg8::ListOrder, true, true>(lds, g, S, E); }
    }
#endif
    xcd_barrier(bar);

#if !defined(ONLY) || ONLY==6
    _Pragma("unroll 1") for (int rep6 = 0; rep6 < REP6; ++rep6) {
        const int b = blk & 7, jc = blk >> 3, qb = jc & 7; char* al = (char*)lds_raw;
        const size_t qrow = (size_t)b * SEQ + qb * 256, krow = (size_t)b * TK;
#if !defined(ATTV) || ATTV==0
#pragma unroll 1
        for (int i = 0; i < 2; ++i) { const int h = (jc >> 3) + 4 * i;
            att::attn_unit<64, 1536, 1024, 1024, 2048>(QA + qrow * 1536 + h * 192, KA + krow * 1024 + h * 128, KPE + krow * 64, VA + krow * 1024 + h * 128, OA + qrow * 2048 + h * 128, TK, al, qb * 256, RT64); }
#endif
#if !defined(ATTV) || ATTV==1
#pragma unroll 1
        for (int i = 0; i < 2; ++i) { const int h = (jc >> 3) + 4 * i, kvh = h >> 2;
            att::attn_unit<0, 1024, 256, 256, 2048>(QB + qrow * 1024 + h * 128, KBm + krow * 256 + kvh * 128, nullptr, VBm + krow * 256 + kvh * 128, OA + qrow * 2048 + 1024 + h * 128, TK, al, qb * 256, RT64); }
#endif
    }
#endif
    xcd_barrier(bar);

#if !defined(ONLY) || ONLY==7
    {
        pg8::StaticOrder S; S.init(MLAT, DM, G, blk);
        { pg8::Gemm g{OA, WBR, MLAT, DM, DM}; pg8::EpiBrH E{GATE, MRG}; pg8::gemm_phase<pg8::EpiBrH, pg8::StaticOrder, true, true>(lds, g, S, E); }
    }
#endif
    xcd_barrier(bar);

#if !defined(ONLY) || ONLY==8
    {
        pg8::Gemm g{MRG, WOUT, MLAT, DM, DM}; pg8::StaticOrder S; S.init(MLAT, DM, G, blk);
        pg8::EpiResB<float> E{A.x, X1B, MOD + 4096};
        pg8::gemm_phase<pg8::EpiResB<float>, pg8::StaticOrder, true, true>(lds, g, S, E);
    }
#endif
    xcd_barrier(bar);

#if !defined(ONLY) || ONLY==9
    {
        PHASE_IDS
        LAS float* SH = (LAS float*)lds; LAS float* SC = SH + 2048;
        const int nper = G / 8, cn = blk / nper, bi = blk % nper;
        for (int idx = tid; idx < 4096; idx += NTHR) SH[idx] = MOD[(size_t)cn * 12288 + 6144 + idx];
        __syncthreads();
        if (cn < 8) { const int st = nper * 8;
            for (int t = bi * 8 + wave; t < SEQ; t += 2 * st) { const int t2 = t + st;
                if (t2 < SEQ) row_norm_mod_bf2(X1B + ((size_t)cn * SEQ + t) * DM, Z2 + ((size_t)cn * SEQ + t) * DM, X1B + ((size_t)cn * SEQ + t2) * DM, Z2 + ((size_t)cn * SEQ + t2) * DM, A.norm2_g, SH, SC, lane);
                else row_norm_mod_bf(X1B + ((size_t)cn * SEQ + t) * DM, Z2 + ((size_t)cn * SEQ + t) * DM, A.norm2_g, SH, SC, lane); } }
    }
#endif
    xcd_barrier(bar);

#if !defined(ONLY) || ONLY==10
    {
        pg8::Gemm g{Z2, WUP, MLAT, NUP, DM}; pg8::StaticOrder S; S.init(MLAT, NUP, G, blk);
        pg8::EpiUpConv E{H, A.conv_w, A.conv_b, PART, RAWB, (LAS float*)(lds + EX_OFF)};
        pg8::gemm_phase<pg8::EpiUpConv, pg8::StaticOrder, true, true>(lds, g, S, E);
    }
#endif
    xcd_barrier(bar);
#if !defined(ONLY) || ONLY==11
    { PHASE_IDS
    for (int it = gw; it < 112 * 22; it += NGW) {
        const int rowi = it / 22, cc = it - rowi * 22, b = rowi / 14, k = rowi - b * 14, jb = k >> 1, s = k & 1;
        const int pm = 8 * b + jb + s, side = s ? 0 : 1, nb = s ? pm - 1 : pm + 1, tap = s ? 0 : 2;
        const int ch = cc * 256 + lane * 4, pn = ch >> 7, cl = ch & 127, col = pn * 256 + cl;
        const float* pp = PART + (size_t)(pm * 2 + side) * 11264 + col; const float* rp = RAWB + (size_t)(nb * 2 + (1 - side)) * 11264 + col;
        const f32x4 ca = *(const f32x4*)pp + *(const f32x4*)(A.conv_w + (size_t)tap * 11264 + ch) * *(const f32x4*)rp;
        const f32x4 cbv = *(const f32x4*)(pp + 128) + *(const f32x4*)(A.conv_w + (size_t)tap * 11264 + 5632 + ch) * *(const f32x4*)(rp + 128);
        const f32x4 h = pg8::silu4(ca) * cbv;
        v2u w; w.x = pk2(h[0], h[1]); w.y = pk2(h[2], h[3]);
        *(v2u*)(H + (size_t)(pm * 256 + (side ? 255 : 0)) * DFF + ch) = w;
    }
    }
#endif
    xcd_barrier(bar);

#if !defined(ONLY) || ONLY==12
    {
        pg8::Gemm g{H, WDN, MLAT, DM, DFF}; pg8::StaticOrder S; S.init(MLAT, DM, G, blk);
        pg8::EpiResB<bf16_t> E{X1B, X2B, MOD + 10240};
        pg8::gemm_phase<pg8::EpiResB<bf16_t>, pg8::StaticOrder, true, true>(lds, g, S, E);
    }
#endif
    xcd_barrier(bar);

#if !defined(ONLY) || ONLY==13
    { PHASE_IDS
    for (int r0 = gw; r0 < MLAT; r0 += 4 * NGW) {
        v4u w[4][4]; float sq[4];
#pragma unroll
        for (int q = 0; q < 4; ++q) { const v4u* xq = (const v4u*)(X2B + (size_t)(r0 + q * NGW) * DM) + lane;
#pragma unroll
            for (int j = 0; j < 4; ++j) w[q][j] = __builtin_nontemporal_load(xq + 64 * j); }
#pragma unroll
        for (int q = 0; q < 4; ++q) { float a2 = 0.f;
#pragma unroll
            for (int j = 0; j < 4; ++j)
#pragma unroll
                for (int e = 0; e < 4; ++e) { const float a = blo(w[q][j][e]), c = bhi(w[q][j][e]); a2 += a * a + c * c; }
            sq[q] = a2; }
#pragma unroll
        for (int o = 1; o < 64; o <<= 1) {
#pragma unroll
            for (int q = 0; q < 4; ++q) sq[q] += __shfl_xor(sq[q], o); }
#pragma unroll
        for (int q = 0; q < 4; ++q) { const float rs = 1.0f / sqrtf(sq[q] * (1.f / 2048.f) + EPS);
#pragma unroll
            for (int j = 0; j < 4; ++j) { const int cidx = (lane + 64 * j) * 8; const f32x4 g0 = *(const f32x4*)(A.final_norm_g + cidx), g1 = *(const f32x4*)(A.final_norm_g + cidx + 4);
                f32x4 o0, o1; o0[0] = blo(w[q][j][0]); o0[1] = bhi(w[q][j][0]); o0[2] = blo(w[q][j][1]); o0[3] = bhi(w[q][j][1]); o1[0] = blo(w[q][j][2]); o1[1] = bhi(w[q][j][2]); o1[2] = blo(w[q][j][3]); o1[3] = bhi(w[q][j][3]);
                f32x4* op = (f32x4*)(A.out + (size_t)(r0 + q * NGW) * DM + cidx); __builtin_nontemporal_store(o0 * rs * g0, op); __builtin_nontemporal_store(o1 * rs * g1, op + 1); } }
    }
    }
#endif
}

extern "C" void kernel_launch(void* const* d_in, const int* in_sizes, int n_in, void* d_out, int out_size, void* d_ws, size_t ws_size, hipStream_t stream) {
    static int grid = 0;
    if (grid == 0) {
        if (n_in != 23 || out_size != MLAT * DM || ws_size < WS_END) { fprintf(stderr, "kernel_launch: unexpected shapes n_in %d out %d ws %zu (need %zu)\n", n_in, out_size, ws_size, (size_t)WS_END); grid = -1; return; }
        int dev = 0, cus = 0, per_cu = 0;
        hipGetDevice(&dev); hipDeviceGetAttribute(&cus, hipDeviceAttributeMultiprocessorCount, dev);
        if (hipFuncSetAttribute((const void*)fwd_megakernel, hipFuncAttributeMaxDynamicSharedMemorySize, LDS_BYTES) != hipSuccess) { fprintf(stderr, "kernel_launch: hipFuncSetAttribute failed\n"); grid = -1; return; }
        if (hipOccupancyMaxActiveBlocksPerMultiprocessor(&per_cu, (const void*)fwd_megakernel, NTHR, LDS_BYTES) != hipSuccess || per_cu < 1) { fprintf(stderr, "kernel_launch: occupancy query failed (%d)\n", per_cu); grid = -1; return; }
        grid = cus;
        if (grid != 256) fprintf(stderr, "kernel_launch: %d CUs; this kernel's schedules assume 256\n", grid);
    }
    if (grid < 0) return;
    if (hipMemsetAsync((char*)d_ws + WS_CTL, 0, CTL_BYTES, stream) != hipSuccess) { fprintf(stderr, "kernel_launch: memset failed\n"); return; }
    Args a{};
    const float** ap = (const float**)&a;
    for (int i = 0; i < 23; ++i) ap[i] = (const float*)d_in[i];
    a.out = (float*)d_out; a.ws = (unsigned char*)d_ws;
    void* args[] = {&a};
    hipError_t e = hipLaunchCooperativeKernel((const void*)fwd_megakernel, dim3(grid), dim3(NTHR), args, LDS_BYTES, stream);
    if (e != hipSuccess) fprintf(stderr, "cooperative launch failed: %s (grid %d)\n", hipGetErrorString(e), grid);
}
```

```cpp
#include <hip/hip_runtime.h>
#include <hip/hip_cooperative_groups.h>
#include <cstdio>
#include <cstdint>
namespace cg = cooperative_groups;
namespace pg8 {
#define PG8_LAS __attribute__((address_space(3)))
typedef unsigned short bf16_t;
typedef short bf16x8 __attribute__((ext_vector_type(8)));
typedef float f32x4 __attribute__((ext_vector_type(4)));
typedef unsigned u32x4 __attribute__((ext_vector_type(4)));
constexpr int BM = 256, BK = 64, HALF = 128, HTB = HALF * BK * 2  , STAGE_BYTES = 8 * HTB, NXCD = 8, WGM = 8;

__host__ __device__ __forceinline__ int lds_byte(int r, int c) { const int st = (r >> 4) * 2 + (c >> 5), rr = r & 15, cc = c & 31, ob = rr * 64 + cc * 2; return st * 1024 + (ob ^ (((ob >> 9) & 1) << 5)); }
__host__ __device__ __forceinline__ void stage_rc(int b, int& R, int& C) { const int st = b / 1024, sb = b % 1024, swz = sb ^ (((sb >> 9) & 1) << 5); R = (st >> 1) * 16 + swz / 64; C = (st & 1) * 32 + (swz % 64) / 2; }
__host__ __device__ __forceinline__ int perm32(int rho) { const int n = rho >> 4, i = rho & 15; return 8 * (i >> 2) + 4 * n + (i & 3); }

struct Unit { int pm, pn; };
struct Gemm { const bf16_t* A; const bf16_t* Bt; int M, N, K; };

struct StaticOrder {
    int nM, nN, nwg, G, c;
    __host__ __device__ void init(int M, int N, int G_, int c_) { nM = M / BM; nN = N / BM; nwg = nM * nN; G = G_; c = c_; }
    __host__ __device__ bool next(int i, Unit& u) const {
        const long L = (long)i * G + c; if (L >= nwg) return false;
        int wgid = (int)L; { const int q = nwg / NXCD, r = nwg % NXCD, xcd = wgid % NXCD, off = wgid / NXCD; wgid = (xcd < r ? xcd * (q + 1) : r * (q + 1) + (xcd - r) * q) + off; }
        const int nig = WGM * nN, gid = wgid / nig, fm = gid * WGM, gsz = (nM - fm) < WGM ? (nM - fm) : WGM;
        u.pm = fm + ((wgid % nig) % gsz); u.pn = (wgid % nig) / gsz; return true;
    }
    __device__ __forceinline__ void a_ready(const Unit&) const {}
    __device__ __forceinline__ void done(const Unit&) const {}
};

__device__ __forceinline__ unsigned cvt_pk_bf16(float lo, float hi) { unsigned r; asm volatile("v_cvt_pk_bf16_f32 %0, %1, %2" : "=v"(r) : "v"(lo), "v"(hi)); return r; }
typedef float f32x2 __attribute__((ext_vector_type(2)));
}
namespace pg8 {
__device__ __forceinline__ float bf2f(unsigned short h) { return __uint_as_float((unsigned)h << 16); }
__device__ __forceinline__ float bflo(unsigned w) { return __uint_as_float(w << 16); }
__device__ __forceinline__ float bfhi(unsigned w) { return __uint_as_float(w & 0xffff0000u); }
struct EpiPlain {
    static constexpr bool PERM = true, AFTER_DRAIN = false, HAS_MID = false;
    bf16_t* O; int ldc;
    __device__ __forceinline__ void operator()(const f32x4 (&acc)[2][2][4][2], const Unit& u, int wr, int wc, int fr, int fq) const {
        const int row0 = u.pm * BM + wr * 64 + fr, col0 = u.pn * BM + wc * 32 + 8 * fq;
#pragma unroll
        for (int ai = 0; ai < 2; ++ai)
#pragma unroll
            for (int m = 0; m < 4; ++m) { bf16_t* rowp = O + (size_t)(row0 + ai * HALF + m * 16) * ldc + col0;
#pragma unroll
                for (int bj = 0; bj < 2; ++bj) { const f32x4 v0 = acc[ai][bj][m][0], v1 = acc[ai][bj][m][1];
                    u32x4 w; w.x = cvt_pk_bf16(v0[0], v0[1]); w.y = cvt_pk_bf16(v0[2], v0[3]); w.z = cvt_pk_bf16(v1[0], v1[1]); w.w = cvt_pk_bf16(v1[2], v1[3]);
                    *(u32x4*)(rowp + bj * HALF) = w; } }
    }
};
struct EpiProj {
    static constexpr bool PERM = true, AFTER_DRAIN = false, HAS_MID = false;
    bf16_t *ckv, *kb, *vb, *kpe, *cq, *qb, *gates;
    __device__ __forceinline__ void operator()(const f32x4 (&acc)[2][2][4][2], const Unit& u, int wr, int wc, int fr, int fq) const {
        const int pn = u.pn, bb = u.pm / 9, jj = u.pm - bb * 9;
        const int rowz0 = u.pm * BM, rowl0 = (bb * 8 + jj - 1) * BM;
        bf16_t* base; int ld, row0, maxcol = 256; bool sig = false;
        if (pn < 2)       { base = ckv + pn * 256; ld = 512; row0 = rowz0; }
        else if (pn == 2) { base = kb; ld = 256; row0 = rowz0; }
        else if (pn == 3) { base = vb; ld = 256; row0 = rowz0; }
        else if (pn == 4) { base = kpe; ld = 64; row0 = rowz0; maxcol = 64; }
        else if (pn < 8)  { base = cq + (pn - 5) * 256; ld = 768; row0 = rowl0; }
        else if (pn < 12) { base = qb + (pn - 8) * 256; ld = 1024; row0 = rowl0; }
        else              { base = gates + (pn - 12) * 256; ld = 4096; row0 = rowl0; sig = true; }
        row0 += wr * 64 + fr; const int col0 = wc * 32 + 8 * fq;
        if (sig) {
            bf16_t* gbase = gates + (pn - 12) * 128 + col0;
#pragma unroll
            for (int ai = 0; ai < 2; ++ai)
#pragma unroll
                for (int m = 0; m < 4; ++m) { bf16_t* rowp = gbase + (size_t)(row0 + ai * HALF + m * 16) * 4096; f32x4 rt[2], gb[2];
#pragma unroll
                    for (int n = 0; n < 2; ++n)
#pragma unroll
                        for (int e = 0; e < 4; ++e) { const float ea = __builtin_amdgcn_exp2f(-1.4426950408889634f * acc[ai][0][m][n][e]), eb = __builtin_amdgcn_exp2f(-1.4426950408889634f * acc[ai][1][m][n][e]);
                            gb[n][e] = __builtin_amdgcn_rcpf(1.f + eb); rt[n][e] = (1.f + eb) * __builtin_amdgcn_rcpf(1.f + ea); }
                    u32x4 w; w.x = cvt_pk_bf16(rt[0][0], rt[0][1]); w.y = cvt_pk_bf16(rt[0][2], rt[0][3]); w.z = cvt_pk_bf16(rt[1][0], rt[1][1]); w.w = cvt_pk_bf16(rt[1][2], rt[1][3]);
                    __builtin_nontemporal_store(w, (u32x4*)rowp);
                    w.x = cvt_pk_bf16(gb[0][0], gb[0][1]); w.y = cvt_pk_bf16(gb[0][2], gb[0][3]); w.z = cvt_pk_bf16(gb[1][0], gb[1][1]); w.w = cvt_pk_bf16(gb[1][2], gb[1][3]);
                    __builtin_nontemporal_store(w, (u32x4*)(rowp + 2048)); }
            return;
        }
#pragma unroll
        for (int ai = 0; ai < 2; ++ai)
#pragma unroll
            for (int m = 0; m < 4; ++m) { bf16_t* rowp = base + (size_t)(row0 + ai * HALF + m * 16) * ld + col0;
#pragma unroll
                for (int bj = 0; bj < 2; ++bj) { if (col0 + bj * HALF < maxcol) { f32x4 v0 = acc[ai][bj][m][0], v1 = acc[ai][bj][m][1];
                    if (sig) {
#pragma unroll
                        for (int e = 0; e < 4; ++e) { v0[e] = __builtin_amdgcn_rcpf(1.f + __builtin_amdgcn_exp2f(-1.4426950408889634f * v0[e])); v1[e] = __builtin_amdgcn_rcpf(1.f + __builtin_amdgcn_exp2f(-1.4426950408889634f * v1[e])); } }
                    u32x4 w; w.x = cvt_pk_bf16(v0[0], v0[1]); w.y = cvt_pk_bf16(v0[2], v0[3]); w.z = cvt_pk_bf16(v1[0], v1[1]); w.w = cvt_pk_bf16(v1[2], v1[3]);
                    if (sig) __builtin_nontemporal_store(w, (u32x4*)(rowp + bj * HALF)); else *(u32x4*)(rowp + bj * HALF) = w; } } }
    }
};
struct EpiKV {
    static constexpr bool PERM = true, AFTER_DRAIN = false, HAS_MID = false;
    bf16_t *ka, *va;
    __device__ __forceinline__ void operator()(const f32x4 (&acc)[2][2][4][2], const Unit& u, int wr, int wc, int fr, int fq) const {
        const int row0 = u.pm * BM + wr * 64 + fr, col0 = u.pn * 128 + wc * 32 + 8 * fq;
#pragma unroll
        for (int ai = 0; ai < 2; ++ai)
#pragma unroll
            for (int m = 0; m < 4; ++m) { const size_t off = (size_t)(row0 + ai * HALF + m * 16) * 1024 + col0;
#pragma unroll
                for (int bj = 0; bj < 2; ++bj) { const f32x4 v0 = acc[ai][bj][m][0], v1 = acc[ai][bj][m][1];
                    u32x4 w; w.x = cvt_pk_bf16(v0[0], v0[1]); w.y = cvt_pk_bf16(v0[2], v0[3]); w.z = cvt_pk_bf16(v1[0], v1[1]); w.w = cvt_pk_bf16(v1[2], v1[3]);
                    *(u32x4*)((bj ? va : ka) + off) = w; } }
    }
};
template <int PASS> struct EpiBr {
    static constexpr bool PERM = true, AFTER_DRAIN = false, HAS_MID = false;
    const bf16_t* gates; bf16_t* O;
    __device__ __forceinline__ void operator()(const f32x4 (&acc)[2][2][4][2], const Unit& u, int wr, int wc, int fr, int fq) const {
        const int row0 = u.pm * BM + wr * 64 + fr, col0 = u.pn * BM + wc * 32 + 8 * fq;
#pragma unroll
        for (int ai = 0; ai < 2; ++ai)
#pragma unroll
            for (int m = 0; m < 4; ++m) { const size_t r = (size_t)(row0 + ai * HALF + m * 16);
#pragma unroll
                for (int bj = 0; bj < 2; ++bj) { const u32x4 b = *(const u32x4*)(gates + r * 4096 + PASS * 2048 + col0 + bj * HALF);
                    f32x4 v0 = acc[ai][bj][m][0], v1 = acc[ai][bj][m][1];
                    v0[0] *= bflo(b[0]); v0[1] *= bfhi(b[0]); v0[2] *= bflo(b[1]); v0[3] *= bfhi(b[1]); v1[0] *= bflo(b[2]); v1[1] *= bfhi(b[2]); v1[2] *= bflo(b[3]); v1[3] *= bfhi(b[3]);
                    if (PASS == 1) { const u32x4 t = *(const u32x4*)(O + r * 2048 + col0 + bj * HALF);
                        v0[0] += bflo(t[0]); v0[1] += bfhi(t[0]); v0[2] += bflo(t[1]); v0[3] += bfhi(t[1]); v1[0] += bflo(t[2]); v1[1] += bfhi(t[2]); v1[2] += bflo(t[3]); v1[3] += bfhi(t[3]); }
                    u32x4 w; w.x = cvt_pk_bf16(v0[0], v0[1]); w.y = cvt_pk_bf16(v0[2], v0[3]); w.z = cvt_pk_bf16(v1[0], v1[1]); w.w = cvt_pk_bf16(v1[2], v1[3]);
                    *(u32x4*)(O + r * 2048 + col0 + bj * HALF) = w; }
                asm volatile("" ::: "memory"); }
    }
};
template <int CTRL> __device__ __forceinline__ float dppf(float old, float src) { return __int_as_float(__builtin_amdgcn_update_dpp(__float_as_int(old), __float_as_int(src), CTRL, 0xf, 0xf, false)); }
template <int CTRL> __device__ __forceinline__ f32x4 dpp4(f32x4 old, f32x4 src) { f32x4 r; r[0] = dppf<CTRL>(old[0], src[0]); r[1] = dppf<CTRL>(old[1], src[1]); r[2] = dppf<CTRL>(old[2], src[2]); r[3] = dppf<CTRL>(old[3], src[3]); return r; }
__device__ __forceinline__ f32x4 silu4(f32x4 x) { f32x4 r;
#pragma unroll
    for (int e = 0; e < 4; ++e) r[e] = x[e] * __builtin_amdgcn_rcpf(1.f + __builtin_amdgcn_exp2f(-1.4426950408889634f * x[e]));
    return r; }
struct EpiUpConv {
    static constexpr bool PERM = true, AFTER_DRAIN = false, HAS_MID = false;
    bf16_t* H; const float* cw; const float* cb; float* PART; float* RAWB; PG8_LAS float* EX;
    __device__ __forceinline__ void operator()(const f32x4 (&acc)[2][2][4][2], const Unit& u, int wr, int wc, int fr, int fq) const {
        const int cl0 = wc * 32 + 8 * fq;
        if (fr == 0) {
#pragma unroll
            for (int ai = 0; ai < 2; ++ai)
#pragma unroll
                for (int bj = 0; bj < 2; ++bj)
#pragma unroll
                    for (int n = 0; n < 2; ++n) *(PG8_LAS f32x4*)(EX + ((2 * ai + wr) * 2 + 0) * 256 + 128 * bj + cl0 + 4 * n) = acc[ai][bj][0][n];
        }
        if (fr == 15) {
#pragma unroll
            for (int ai = 0; ai < 2; ++ai)
#pragma unroll
                for (int bj = 0; bj < 2; ++bj)
#pragma unroll
                    for (int n = 0; n < 2; ++n) *(PG8_LAS f32x4*)(EX + ((2 * ai + wr) * 2 + 1) * 256 + 128 * bj + cl0 + 4 * n) = acc[ai][bj][3][n];
        }
        asm volatile("s_waitcnt lgkmcnt(0)" ::: "memory"); __builtin_amdgcn_s_barrier(); asm volatile("" ::: "memory");
        typedef unsigned u32x2 __attribute__((ext_vector_type(2)));
        u32x2 pk0[2][4];
        const f32x4 z4 = (f32x4){0.f, 0.f, 0.f, 0.f};
#pragma unroll
        for (int n = 0; n < 2; ++n) {
            const int ch = u.pn * 128 + cl0 + 4 * n;
            const f32x4 w0a = *(const f32x4*)(cw + ch), w1a = *(const f32x4*)(cw + 11264 + ch), w2a = *(const f32x4*)(cw + 2 * 11264 + ch);
            const f32x4 w0b = *(const f32x4*)(cw + 5632 + ch), w1b = *(const f32x4*)(cw + 11264 + 5632 + ch), w2b = *(const f32x4*)(cw + 2 * 11264 + 5632 + ch);
            const f32x4 ba = *(const f32x4*)(cb + ch), bb = *(const f32x4*)(cb + 5632 + ch);
#pragma unroll
            for (int ai = 0; ai < 2; ++ai) {
                const int q = 2 * ai + wr;
                f32x4 haf = z4, hbf = z4, hal = z4, hbl = z4;
                if (q > 0) { haf = *(const PG8_LAS f32x4*)(EX + ((q - 1) * 2 + 1) * 256 + cl0 + 4 * n); hbf = *(const PG8_LAS f32x4*)(EX + ((q - 1) * 2 + 1) * 256 + 128 + cl0 + 4 * n); }
                if (q < 3) { hal = *(const PG8_LAS f32x4*)(EX + ((q + 1) * 2) * 256 + cl0 + 4 * n); hbl = *(const PG8_LAS f32x4*)(EX + ((q + 1) * 2) * 256 + 128 + cl0 + 4 * n); }
#pragma unroll
                for (int m = 0; m < 4; ++m) {
                    const f32x4 va = acc[ai][0][m][n], vb = acc[ai][1][m][n];
                    f32x4 xa, xb, ya, yb;
                    if (m == 0) { xa = haf; xb = hbf; } else { xa = dpp4<0x121>(va, acc[ai][0][m - 1][n]); xb = dpp4<0x121>(vb, acc[ai][1][m - 1][n]); }
                    if (m == 3) { ya = hal; yb = hbl; } else { ya = dpp4<0x12F>(va, acc[ai][0][m + 1][n]); yb = dpp4<0x12F>(vb, acc[ai][1][m + 1][n]); }
                    const f32x4 pa = dpp4<0x111>(xa, va), pb = dpp4<0x111>(xb, vb);
                    const f32x4 na = dpp4<0x101>(ya, va), nb = dpp4<0x101>(yb, vb);
                    const f32x4 ca = ba + w0a * pa + w1a * va + w2a * na, cbv = bb + w0b * pb + w1b * vb + w2b * nb;
                    if (q == 0 && m == 0) { if (fr == 0) { const size_t o = (size_t)(u.pm * 2 + 0) * 11264 + u.pn * 256 + cl0 + 4 * n;
                        *(f32x4*)(PART + o) = ca; *(f32x4*)(PART + o + 128) = cbv; *(f32x4*)(RAWB + o) = va; *(f32x4*)(RAWB + o + 128) = vb; } }
                    if (q == 3 && m == 3) { if (fr == 15) { const size_t o = (size_t)(u.pm * 2 + 1) * 11264 + u.pn * 256 + cl0 + 4 * n;
                        *(f32x4*)(PART + o) = ca; *(f32x4*)(PART + o + 128) = cbv; *(f32x4*)(RAWB + o) = va; *(f32x4*)(RAWB + o + 128) = vb; } }
                    const f32x4 h = silu4(ca) * cbv;
                    u32x2 pk; pk.x = cvt_pk_bf16(h[0], h[1]); pk.y = cvt_pk_bf16(h[2], h[3]);
                    if (n == 0) pk0[ai][m] = pk;
                    else { u32x4 w; w.x = pk0[ai][m].x; w.y = pk0[ai][m].y; w.z = pk.x; w.w = pk.y;
                        __builtin_nontemporal_store(w, (u32x4*)(H + (size_t)(u.pm * BM + ai * HALF + wr * 64 + m * 16 + fr) * 5632 + u.pn * 128 + cl0)); }
                }
            }
        }
    }
};
struct EpiBrH {
    static constexpr bool PERM = true, AFTER_DRAIN = false, HAS_MID = true;
    const bf16_t* gates; bf16_t* O;
    __device__ __forceinline__ void mid(f32x4 (&acc)[2][2][4][2], const Unit& u, int wr, int wc, int fr, int fq) const {
        int row0 = u.pm * BM + wr * 64 + fr, col0 = u.pn * BM + wc * 32 + 8 * fq;
        asm volatile("" : "+v"(row0), "+v"(col0) :: "memory");
#pragma unroll
        for (int ai = 0; ai < 2; ++ai)
#pragma unroll
            for (int m = 0; m < 4; ++m) {
                int roff = row0 + ai * HALF + m * 16; asm volatile("" : "+v"(roff) :: "memory"); const bf16_t* gp = gates + (size_t)roff * 4096 + col0;
#pragma unroll
                for (int bj = 0; bj < 2; ++bj) { const u32x4 a = __builtin_nontemporal_load((const u32x4*)(gp + bj * HALF));
                    f32x4 r0, r1;
                    r0[0] = bflo(a[0]); r0[1] = bfhi(a[0]); r0[2] = bflo(a[1]); r0[3] = bfhi(a[1]); r1[0] = bflo(a[2]); r1[1] = bfhi(a[2]); r1[2] = bflo(a[3]); r1[3] = bfhi(a[3]);
                    acc[ai][bj][m][0] = acc[ai][bj][m][0] * r0; acc[ai][bj][m][1] = acc[ai][bj][m][1] * r1; }
                asm volatile("" : "+v"(acc[ai][0][m][0]), "+v"(acc[ai][0][m][1]), "+v"(acc[ai][1][m][0]), "+v"(acc[ai][1][m][1]));
                __builtin_amdgcn_sched_barrier(0);
            }
    }
    __device__ __forceinline__ void operator()(const f32x4 (&acc)[2][2][4][2], const Unit& u, int wr, int wc, int fr, int fq) const {
        const int row0 = u.pm * BM + wr * 64 + fr, col0 = u.pn * BM + wc * 32 + 8 * fq;
#pragma unroll
        for (int ai = 0; ai < 2; ++ai)
#pragma unroll
            for (int m = 0; m < 4; ++m) { const size_t r = (size_t)(row0 + ai * HALF + m * 16);
#pragma unroll
                for (int bj = 0; bj < 2; ++bj) { const u32x4 b = *(const u32x4*)(gates + r * 4096 + 2048 + col0 + bj * HALF);
                    const f32x4 v0 = acc[ai][bj][m][0], v1 = acc[ai][bj][m][1];
                    u32x4 w; w.x = cvt_pk_bf16(v0[0] * bflo(b[0]), v0[1] * bfhi(b[0])); w.y = cvt_pk_bf16(v0[2] * bflo(b[1]), v0[3] * bfhi(b[1]));
                    w.z = cvt_pk_bf16(v1[0] * bflo(b[2]), v1[1] * bfhi(b[2])); w.w = cvt_pk_bf16(v1[2] * bflo(b[3]), v1[3] * bfhi(b[3]));
                    *(u32x4*)(O + r * 2048 + col0 + bj * HALF) = w; }
                asm volatile("" ::: "memory"); }
    }
};
struct EpiRes {
    static constexpr bool PERM = false, AFTER_DRAIN = false, HAS_MID = false;
    const float* base; float* out; const float* g;
    __device__ __forceinline__ void operator()(const f32x4 (&acc)[2][2][4][2], const Unit& u, int wr, int wc, int fr, int fq) const {
        const int row0 = u.pm * BM + wr * 64 + fr, col0 = u.pn * BM + wc * 32 + 4 * fq;
        const float* gb = g + (size_t)(u.pm >> 3) * 12288 + col0;
        f32x4 gv[2][2];
#pragma unroll
        for (int bj = 0; bj < 2; ++bj)
#pragma unroll
            for (int n = 0; n < 2; ++n) gv[bj][n] = *(const f32x4*)(gb + bj * HALF + n * 16);
#pragma unroll
        for (int ai = 0; ai < 2; ++ai)
#pragma unroll
            for (int m = 0; m < 4; ++m) { const size_t off = (size_t)(row0 + ai * HALF + m * 16) * 2048 + col0;
#pragma unroll
                for (int bj = 0; bj < 2; ++bj)
#pragma unroll
                    for (int n = 0; n < 2; ++n) { const f32x4 bs = *(const f32x4*)(base + off + bj * HALF + n * 16);
                        *(f32x4*)(out + off + bj * HALF + n * 16) = bs + gv[bj][n] * acc[ai][bj][m][n]; } }
    }
};
template <typename TB> struct EpiResB {
    static constexpr bool PERM = true, AFTER_DRAIN = false, HAS_MID = false;
    const TB* base; bf16_t* out; const float* g;
    __device__ __forceinline__ void operator()(const f32x4 (&acc)[2][2][4][2], const Unit& u, int wr, int wc, int fr, int fq) const {
        const int row0 = u.pm * BM + wr * 64 + fr, col0 = u.pn * BM + wc * 32 + 8 * fq;
        const float* gb = g + (size_t)(u.pm >> 3) * 12288 + col0;
        f32x4 gv[2][2];
#pragma unroll
        for (int bj = 0; bj < 2; ++bj)
#pragma unroll
            for (int n = 0; n < 2; ++n) gv[bj][n] = *(const f32x4*)(gb + bj * HALF + n * 4);
#pragma unroll
        for (int ai = 0; ai < 2; ++ai)
#pragma unroll
            for (int m = 0; m < 4; ++m) { const size_t off = (size_t)(row0 + ai * HALF + m * 16) * 2048 + col0;
#pragma unroll
                for (int bj = 0; bj < 2; ++bj) { f32x4 b0, b1;
                    if constexpr (sizeof(TB) == 4) { b0 = __builtin_nontemporal_load((const f32x4*)((const float*)base + off + bj * HALF)); b1 = __builtin_nontemporal_load((const f32x4*)((const float*)base + off + bj * HALF + 4)); }
                    else { const u32x4 t = *(const u32x4*)((const bf16_t*)base + off + bj * HALF);
                        b0[0] = bflo(t[0]); b0[1] = bfhi(t[0]); b0[2] = bflo(t[1]); b0[3] = bfhi(t[1]); b1[0] = bflo(t[2]); b1[1] = bfhi(t[2]); b1[2] = bflo(t[3]); b1[3] = bfhi(t[3]); }
                    const f32x4 v0 = b0 + gv[bj][0] * acc[ai][bj][m][0], v1 = b1 + gv[bj][1] * acc[ai][bj][m][1];
                    u32x4 w; w.x = cvt_pk_bf16(v0[0], v0[1]); w.y = cvt_pk_bf16(v0[2], v0[3]); w.z = cvt_pk_bf16(v1[0], v1[1]); w.w = cvt_pk_bf16(v1[2], v1[3]);
                    *(u32x4*)(out + off + bj * HALF) = w; } }
    }
};
struct ProjOrder {
    StaticOrder so; int G, c;
    __device__ void init(int G_, int c_) { so.init(16384, 7168, G_, c_); G = G_; c = c_; }
    __device__ bool next(int i, Unit& u) const {
        const long L = (long)i * G + c;
        if (L < 1792) { Unit t; so.next(i, t); u.pm = (t.pm >> 3) * 9 + 1 + (t.pm & 7); u.pn = t.pn; return true; }
        if (L < 1832) { const int q = (int)(L - 1792); u.pm = (q / 5) * 9; u.pn = q % 5; return true; }
        return false;
    }
    __device__ __forceinline__ void a_ready(const Unit&) const {}
    __device__ __forceinline__ void done(const Unit&) const {}
};
struct ListOrder {
    int first, n, rows, rowbase;
    __device__ bool next(int i, Unit& u) const { if (i >= n) return false; const int q = first + i; u.pm = rowbase + q % rows; u.pn = q / rows; return true; }
    __device__ __forceinline__ void a_ready(const Unit&) const {}
    __device__ __forceinline__ void done(const Unit&) const {}
};
}
namespace pg8 {
template <class Epi, class Sched, bool ALIGN_EPI = false, bool SP2 = false>
__device__ __forceinline__ void gemm_phase(PG8_LAS unsigned char* lds, const Gemm g, const Sched& S, const Epi& E) {
    int tid = threadIdx.x; asm volatile("" : "+v"(tid));
    const int wid = __builtin_amdgcn_readfirstlane(tid >> 6), lane = tid & 63, wr = wid >> 2, wc = wid & 3, fr = lane & 15, fq = lane >> 4;
    const int K = g.K, nt = K / BK;
    unsigned voffA[2], voffB[2];
#pragma unroll
    for (int i = 0; i < 2; ++i) { int R, C; stage_rc(tid * 16 + i * 8192, R, C); const int Rb = Epi::PERM ? ((R & ~31) + perm32(R & 31)) : R;
        voffA[i] = (unsigned)(R * K + C) * 2u; voffB[i] = (unsigned)(Rb * K + C) * 2u; }
    const size_t kstep = (size_t)(BK * 2);
    const size_t hstep = (size_t)HALF * K * 2;
    const size_t tstep = 2 * hstep;
    const unsigned ldsw = (unsigned)wid * 1024u;
    const int aoff = lds_byte(wr * 64 + fr, fq * 8), boff = lds_byte(wc * 32 + fr, fq * 8);
#define PG8_SA(b, h) (((b) * 2 + (h)) * HTB)
#define PG8_SB(b, h) ((4 + (b) * 2 + (h)) * HTB)
#define PG8_STAGE(bufoff, gbase, voff) do { _Pragma("unroll") for (int _i = 0; _i < 2; ++_i) \
        __builtin_amdgcn_global_load_lds((const unsigned*)((const char*)(gbase) + (voff)[_i]), (PG8_LAS unsigned*)(lds + (bufoff) + ldsw + _i * 8192), 16, 0, 0); } while (0)
#define PG8_LDA(dst, b, h) do { _Pragma("unroll") for (int m = 0; m < 4; ++m) _Pragma("unroll") for (int k = 0; k < 2; ++k) dst[m][k] = *(const PG8_LAS bf16x8*)(lds + PG8_SA(b, h) + aoff + m * 2048 + k * 1024); } while (0)
#define PG8_LDB(dst, b, h) do { _Pragma("unroll") for (int n = 0; n < 2; ++n) _Pragma("unroll") for (int k = 0; k < 2; ++k) dst[n][k] = *(const PG8_LAS bf16x8*)(lds + PG8_SB(b, h) + boff + n * 2048 + k * 1024); } while (0)
#define PG8_MMA(ai, bj, At, Bt) do { __builtin_amdgcn_s_setprio(1); _Pragma("unroll") for (int m = 0; m < 4; ++m) _Pragma("unroll") for (int n = 0; n < 2; ++n) _Pragma("unroll") for (int k = 0; k < 2; ++k) \
        acc[ai][bj][m][n] = __builtin_amdgcn_mfma_f32_16x16x32_bf16(Bt[n][k], At[m][k], acc[ai][bj][m][n], 0, 0, 0); __builtin_amdgcn_s_setprio(0); } while (0)
#define PG8_WAIT_V(n) asm volatile("s_waitcnt vmcnt(" #n ")" ::: "memory")
#define PG8_WAIT_L(n) asm volatile("s_waitcnt lgkmcnt(" #n ")" ::: "memory")
#define PG8_BAR __builtin_amdgcn_s_barrier()
#define PG8_SCHED __builtin_amdgcn_sched_barrier(0)
    Unit cur, nxt; int ui = 0;
    if (!S.next(0, cur)) return;
    f32x4 acc[2][2][4][2];
#pragma unroll
    for (int a = 0; a < 2; ++a)
#pragma unroll
        for (int b = 0; b < 2; ++b)
#pragma unroll
            for (int m = 0; m < 4; ++m)
#pragma unroll
                for (int n = 0; n < 2; ++n) acc[a][b][m][n] = (f32x4){0.f, 0.f, 0.f, 0.f};
    bf16x8 At[4][2], B0[2][2], B1[2][2];
    const char* cA = (const char*)g.A + (size_t)cur.pm * tstep; const char* cB = (const char*)g.Bt + (size_t)cur.pn * tstep;
    S.a_ready(cur);
    if constexpr (SP2) {
        PG8_STAGE(PG8_SB(0, 0), cB, voffB); PG8_STAGE(PG8_SB(0, 1), cB + hstep, voffB); PG8_STAGE(PG8_SA(0, 0), cA, voffA); PG8_STAGE(PG8_SA(0, 1), cA + hstep, voffA);
        if (wr == 1) PG8_BAR;
        PG8_WAIT_V(2); PG8_BAR;
        PG8_STAGE(PG8_SB(1, 0), cB + kstep, voffB); PG8_STAGE(PG8_SA(1, 0), cA + kstep, voffA); PG8_STAGE(PG8_SB(1, 1), cB + hstep + kstep, voffB);
        PG8_WAIT_V(6); PG8_BAR;
    } else {
        PG8_STAGE(PG8_SB(0, 0), cB, voffB); PG8_STAGE(PG8_SA(0, 0), cA, voffA); PG8_STAGE(PG8_SB(0, 1), cB + hstep, voffB); PG8_STAGE(PG8_SA(0, 1), cA + hstep, voffA);
        if (wr == 1) PG8_BAR;
        PG8_WAIT_V(4); PG8_BAR;
        PG8_STAGE(PG8_SB(1, 0), cB + kstep, voffB); PG8_STAGE(PG8_SA(1, 0), cA + kstep, voffA); PG8_STAGE(PG8_SB(1, 1), cB + hstep + kstep, voffB);
        PG8_WAIT_V(6); PG8_BAR;
    }
    for (;;) {
        const bool has_next = S.next(ui + 1, nxt);
        const char* nA = has_next ? (const char*)g.A + (size_t)nxt.pm * tstep : cA; const char* nB = has_next ? (const char*)g.Bt + (size_t)nxt.pn * tstep : cB;
        constexpr int NSEG = Epi::HAS_MID ? 2 : 1; const int tseg = nt / NSEG;
#pragma unroll
        for (int seg = 0; seg < NSEG; ++seg) {
        if constexpr (Epi::HAS_MID) { if (seg == 1) E.mid(acc, cur, wr, wc, fr, fq); }
        for (int t = seg * tseg; t < (seg + 1) * tseg; t += 2) {
            const bool last = (t == nt - 2);
            const char* a1 = cA + (size_t)(t + 1) * kstep;
            const char* a2 = last ? nA : cA + (size_t)(t + 2) * kstep; const char* b2 = last ? nB : cB + (size_t)(t + 2) * kstep;
            const char* a3 = a2 + kstep; const char* b3 = b2 + kstep;
            if (last && has_next) S.a_ready(nxt);
            if constexpr (SP2) {
            PG8_LDB(B0, 0, 0); PG8_LDB(B1, 0, 1); PG8_SCHED; PG8_LDA(At, 0, 0); PG8_STAGE(PG8_SA(1, 1), a1 + hstep, voffA);
            PG8_WAIT_V(8); PG8_WAIT_L(0); PG8_BAR; PG8_MMA(0, 0, At, B0); PG8_MMA(0, 1, At, B1); PG8_BAR; PG8_SCHED;
            PG8_LDA(At, 0, 1); PG8_STAGE(PG8_SB(0, 0), b2, voffB); PG8_STAGE(PG8_SB(0, 1), b2 + hstep, voffB); PG8_STAGE(PG8_SA(0, 0), a2, voffA);
            PG8_WAIT_V(8); PG8_WAIT_L(0); PG8_BAR; PG8_MMA(1, 0, At, B0); PG8_MMA(1, 1, At, B1); PG8_BAR; PG8_SCHED;
            PG8_LDB(B0, 1, 0); PG8_LDB(B1, 1, 1); PG8_SCHED; PG8_LDA(At, 1, 0); PG8_STAGE(PG8_SA(0, 1), a2 + hstep, voffA);
            PG8_WAIT_V(8); PG8_WAIT_L(0); PG8_BAR; PG8_MMA(0, 0, At, B0); PG8_MMA(0, 1, At, B1); PG8_BAR; PG8_SCHED;
            PG8_LDA(At, 1, 1); PG8_STAGE(PG8_SB(1, 0), b3, voffB); PG8_STAGE(PG8_SB(1, 1), b3 + hstep, voffB); PG8_STAGE(PG8_SA(1, 0), a3, voffA);
            PG8_WAIT_V(8); PG8_WAIT_L(0); PG8_BAR; PG8_MMA(1, 0, At, B0); PG8_MMA(1, 1, At, B1); PG8_BAR; PG8_SCHED;
            } else {
            PG8_LDB(B0, 0, 0); PG8_SCHED; PG8_LDA(At, 0, 0); PG8_STAGE(PG8_SA(1, 1), a1 + hstep, voffA);
            PG8_WAIT_L(8); PG8_BAR; PG8_WAIT_L(0); PG8_MMA(0, 0, At, B0); PG8_BAR; PG8_SCHED;
            PG8_LDB(B1, 0, 1); PG8_STAGE(PG8_SB(0, 0), b2, voffB);
            PG8_BAR; PG8_WAIT_L(0); PG8_MMA(0, 1, At, B1); PG8_BAR;
            PG8_LDA(At, 0, 1); PG8_STAGE(PG8_SA(0, 0), a2, voffA);
            PG8_BAR; PG8_WAIT_L(0); PG8_MMA(1, 0, At, B0); PG8_BAR; PG8_SCHED;
            PG8_STAGE(PG8_SB(0, 1), b2 + hstep, voffB);
            PG8_WAIT_V(6); PG8_BAR; PG8_MMA(1, 1, At, B1); PG8_BAR;
            PG8_LDB(B0, 1, 0); PG8_SCHED; PG8_LDA(At, 1, 0); PG8_STAGE(PG8_SA(0, 1), a2 + hstep, voffA);
            PG8_WAIT_L(8); PG8_BAR; PG8_WAIT_L(0); PG8_MMA(0, 0, At, B0); PG8_BAR; PG8_SCHED;
            PG8_LDB(B1, 1, 1); PG8_STAGE(PG8_SB(1, 0), b3, voffB);
            PG8_BAR; PG8_WAIT_L(0); PG8_MMA(0, 1, At, B1); PG8_BAR;
            PG8_LDA(At, 1, 1); PG8_STAGE(PG8_SA(1, 0), a3, voffA);
            PG8_BAR; PG8_WAIT_L(0); PG8_MMA(1, 0, At, B0); PG8_BAR; PG8_SCHED;
            PG8_STAGE(PG8_SB(1, 1), b3 + hstep, voffB);
            PG8_WAIT_V(6); PG8_BAR; PG8_MMA(1, 1, At, B1); PG8_BAR;
            }
        }
        }
        if constexpr (ALIGN_EPI) { if (wr == 0) PG8_BAR; }
        if constexpr (!Epi::AFTER_DRAIN) { E(acc, cur, wr, wc, fr, fq); S.done(cur); }
        if (!has_next) break;
#pragma unroll
        for (int a = 0; a < 2; ++a)
#pragma unroll
            for (int b = 0; b < 2; ++b)
#pragma unroll
                for (int m = 0; m < 4; ++m)
#pragma unroll
                    for (int n = 0; n < 2; ++n) acc[a][b][m][n] = (f32x4){0.f, 0.f, 0.f, 0.f};
        cur = nxt; cA = nA; cB = nB; ++ui;
        if constexpr (ALIGN_EPI) { if (wr == 1) PG8_BAR; }
    }
    PG8_WAIT_V(0);
    if constexpr (!ALIGN_EPI) { if (wr == 0) PG8_BAR; }
    PG8_BAR;
    if constexpr (Epi::AFTER_DRAIN) { E.fused(acc, cur, wr, wc, fr, fq, lds, wid, lane); S.done(cur); }
#undef PG8_SA
#undef PG8_SB
#undef PG8_STAGE
#undef PG8_LDA
#undef PG8_LDB
#undef PG8_MMA
#undef PG8_WAIT_V
#undef PG8_WAIT_L
#undef PG8_BAR
#undef PG8_SCHED
}
}

namespace att {
using bf16_t = unsigned short;
using bf16x8 = __attribute__((ext_vector_type(8))) short;
using s16x4  = __attribute__((ext_vector_type(4))) short;
using f32x16 = __attribute__((ext_vector_type(16))) float;
using u32x4  = __attribute__((ext_vector_type(4))) unsigned;
constexpr int D = 128, NW = 8, QBLK = 32, KVBLK = 64;
#ifndef NQL
#define NQL 5
#endif
#ifndef NQL0
#define NQL0 0
#endif
#ifndef MLA_SD
#define MLA_SD 1
#endif
constexpr float THR = 8.f;
constexpr int SHM_V = KVBLK * D * 2, SHM_K = KVBLK * D * 2, SHM_KR = KVBLK * 64 * 2;
constexpr int OFF_V = 0, OFF_K = 2 * SHM_V, OFF_WS = OFF_K + 2 * SHM_K, OFF_KR = OFF_WS + NW * 64 * 4, OFF_QR = OFF_KR + 2 * SHM_KR, QRW = (4 + NQL) * 1024, LDS_BYTES = OFF_QR + NW * QRW;
#define KSWZ(row, colB) ((row) * 256 + ((colB) ^ (((row) & 15) << 4)))
#define KRSWZ(row, colB) ((row) * 128 + ((colB) ^ ((((row) >> 1) & 7) << 4)))
#define SBAR() __builtin_amdgcn_sched_barrier(0)
__device__ __forceinline__ int crow(int r, int hi) { return (r & 3) + 8 * (r >> 2) + 4 * hi; }
__device__ __forceinline__ unsigned cvtpk(float lo, float hi) { unsigned r; asm volatile("v_cvt_pk_bf16_f32 %0, %1, %2" : "=v"(r) : "v"(lo), "v"(hi)); return r; }
__device__ __forceinline__ void partialSM(f32x16& p0, f32x16& p1, float& m_reg, float& mn, float& alpha, const float SCALE) {
  const float C = SCALE * 1.4426950408889634f;
  float pmax = p0[0];
#pragma unroll
  for (int r = 1; r < 16; ++r) pmax = fmaxf(pmax, p0[r]);
#pragma unroll
  for (int r = 0; r < 16; ++r) pmax = fmaxf(pmax, p1[r]);
  { auto rr = __builtin_amdgcn_permlane32_swap(__float_as_uint(pmax), __float_as_uint(pmax), false, false);
    pmax = fmaxf(__uint_as_float(rr[0]), __uint_as_float(rr[1])); }
  if (__builtin_expect(__all(pmax - m_reg <= THR / SCALE), 1)) { mn = m_reg; alpha = 1.f; }
  else { mn = fmaxf(m_reg, pmax); alpha = __builtin_amdgcn_exp2f((m_reg - mn) * C); m_reg = mn; }
  float mnC = -mn * C;
#pragma unroll
  for (int r = 0; r < 16; ++r) p0[r] = fmaf(p0[r], C, mnC);
#pragma unroll
  for (int r = 0; r < 16; ++r) p1[r] = fmaf(p1[r], C, mnC);
#pragma unroll
  for (int r = 0; r < 16; ++r) p0[r] = __builtin_amdgcn_exp2f(p0[r]);
}
__device__ __forceinline__ void finishSM(f32x16& p0, f32x16& p1, float alpha, float& l_reg, bf16x8& pa0, bf16x8& pa1, bf16x8& pa2, bf16x8& pa3) {
#pragma unroll
  for (int r = 0; r < 16; ++r) p1[r] = __builtin_amdgcn_exp2f(p1[r]);
  float ps = 0;
#pragma unroll
  for (int r = 0; r < 16; ++r) ps += p0[r];
#pragma unroll
  for (int r = 0; r < 16; ++r) ps += p1[r];
  { auto rr = __builtin_amdgcn_permlane32_swap(__float_as_uint(ps), __float_as_uint(ps), false, false);
    ps = __uint_as_float(rr[0]) + __uint_as_float(rr[1]); }
  l_reg = l_reg * alpha + ps;
#define PK4(P, BASE, OUT) do { unsigned a0 = cvtpk(P[BASE + 0], P[BASE + 1]), a1 = cvtpk(P[BASE + 2], P[BASE + 3]);   \
    unsigned b0 = cvtpk(P[BASE + 4], P[BASE + 5]), b1 = cvtpk(P[BASE + 6], P[BASE + 7]);                              \
    auto r0 = __builtin_amdgcn_permlane32_swap(a0, b0, false, false); auto r1 = __builtin_amdgcn_permlane32_swap(a1, b1, false, false); \
    u32x4 w = {r0[0], r1[0], r0[1], r1[1]}; OUT = *reinterpret_cast<bf16x8*>(&w); } while (0)
  PK4(p0, 0, pa0); PK4(p0, 8, pa1); PK4(p1, 0, pa2); PK4(p1, 8, pa3);
#undef PK4
}
template <int DKR, int NQ>
__device__ __forceinline__ void qkt(f32x16& p0, f32x16& p1, const char* Ks, const char* Krs, const char* Qrs, const bf16x8* qr, int r32, int hi, int lane) {
  p0 = f32x16{}; p1 = f32x16{};
#pragma unroll
  for (int d0 = 0; d0 < 8; ++d0) { int cb = (d0 * 16 + hi * 8) * 2;
    bf16x8 b0 = *reinterpret_cast<const bf16x8*>(Ks + KSWZ(r32, cb));
    bf16x8 b1 = *reinterpret_cast<const bf16x8*>(Ks + KSWZ(32 + r32, cb));
    bf16x8 qf;
    if (d0 >= 8 - NQ) qf = *reinterpret_cast<const bf16x8*>(Qrs + (d0 - (8 - NQ) + 4) * 1024 + lane * 16); else qf = qr[d0];
    p0 = __builtin_amdgcn_mfma_f32_32x32x16_bf16(b0, qf, p0, 0, 0, 0);
    p1 = __builtin_amdgcn_mfma_f32_32x32x16_bf16(b1, qf, p1, 0, 0, 0); }
  if constexpr (DKR > 0) {
    SBAR();
#pragma unroll
    for (int d0 = 0; d0 < DKR / 16; ++d0) { int cb = (d0 * 16 + hi * 8) * 2;
      bf16x8 b0 = *reinterpret_cast<const bf16x8*>(Krs + KRSWZ(r32, cb));
      bf16x8 b1 = *reinterpret_cast<const bf16x8*>(Krs + KRSWZ(32 + r32, cb));
      bf16x8 qf = *reinterpret_cast<const bf16x8*>(Qrs + d0 * 1024 + lane * 16);
      p0 = __builtin_amdgcn_mfma_f32_32x32x16_bf16(b0, qf, p0, 0, 0, 0);
      p1 = __builtin_amdgcn_mfma_f32_32x32x16_bf16(b1, qf, p1, 0, 0, 0); }
  }
}
__device__ __forceinline__ int v_st(int k, int c) { const int kk = (k & ~0xC) | ((k & 4) << 1) | ((k & 8) >> 1); return ((kk >> 3) * 4 + (c >> 5)) * 512 + ((kk & 7) * 32 + (c & 31)) * 2; }
__device__ __forceinline__ int v_rd_base(int lane) { return ((lane & 3) << 3) | (((lane >> 2) & 3) << 6) | (((lane >> 4) & 1) << 5) | (((lane >> 5) & 1) << 8); }
constexpr int v_rd_off(int d0, int ks, int half) { return d0 * 512 + ks * 4096 + half * 2048; }
template <int OFF> __device__ __forceinline__ s16x4 tr_read(int vb) {
  s16x4 r; asm volatile("ds_read_b64_tr_b16 %0, %1 offset:%2" : "=&v"(r) : "v"(vb), "i"(OFF) : "memory"); return r;
}
template <int D0> __device__ __forceinline__ void pv_one(f32x16& od, int vb, bf16x8 pa0, bf16x8 pa1, bf16x8 pa2, bf16x8 pa3) {
  const s16x4 l0 = tr_read<v_rd_off(D0, 0, 0)>(vb), h0 = tr_read<v_rd_off(D0, 0, 1)>(vb), l1 = tr_read<v_rd_off(D0, 1, 0)>(vb), h1 = tr_read<v_rd_off(D0, 1, 1)>(vb);
  const s16x4 l2 = tr_read<v_rd_off(D0, 2, 0)>(vb), h2 = tr_read<v_rd_off(D0, 2, 1)>(vb), l3 = tr_read<v_rd_off(D0, 3, 0)>(vb), h3 = tr_read<v_rd_off(D0, 3, 1)>(vb);
  asm volatile("s_waitcnt lgkmcnt(0)" ::: "memory"); SBAR();
#define PK(L, H) (bf16x8){L[0], L[1], L[2], L[3], H[0], H[1], H[2], H[3]}
  od = __builtin_amdgcn_mfma_f32_32x32x16_bf16(pa0, PK(l0, h0), od, 0, 0, 0);
  od = __builtin_amdgcn_mfma_f32_32x32x16_bf16(pa1, PK(l1, h1), od, 0, 0, 0);
  od = __builtin_amdgcn_mfma_f32_32x32x16_bf16(pa2, PK(l2, h2), od, 0, 0, 0);
  od = __builtin_amdgcn_mfma_f32_32x32x16_bf16(pa3, PK(l3, h3), od, 0, 0, 0);
#undef PK
}
__device__ __forceinline__ void pv_d0(f32x16* o, int vb, bf16x8 pa0, bf16x8 pa1, bf16x8 pa2, bf16x8 pa3) {
  pv_one<0>(o[0], vb, pa0, pa1, pa2, pa3); pv_one<1>(o[1], vb, pa0, pa1, pa2, pa3); pv_one<2>(o[2], vb, pa0, pa1, pa2, pa3); pv_one<3>(o[3], vb, pa0, pa1, pa2, pa3);
}
__device__ __forceinline__ void pv_sm(f32x16* o, int vb, bf16x8 pa0, bf16x8 pa1, bf16x8 pa2, bf16x8 pa3, f32x16& p0, f32x16& p1, float& m_reg, float& mn, float& alpha, const float SCALE) {
  const float C = SCALE * 1.4426950408889634f;
  pv_one<0>(o[0], vb, pa0, pa1, pa2, pa3);
  float pmax = p0[0];
#pragma unroll
  for (int r = 1; r < 16; ++r) pmax = fmaxf(pmax, p0[r]);
  pv_one<1>(o[1], vb, pa0, pa1, pa2, pa3);
#pragma unroll
  for (int r = 0; r < 16; ++r) pmax = fmaxf(pmax, p1[r]);
  { auto rr = __builtin_amdgcn_permlane32_swap(__float_as_uint(pmax), __float_as_uint(pmax), false, false);
    pmax = fmaxf(__uint_as_float(rr[0]), __uint_as_float(rr[1])); }
  if (__builtin_expect(__all(pmax - m_reg <= THR / SCALE), 1)) { mn = m_reg; alpha = 1.f; }
  else { mn = fmaxf(m_reg, pmax); alpha = __builtin_amdgcn_exp2f((m_reg - mn) * C); m_reg = mn; }
  const float mnC = -mn * C;
  pv_one<2>(o[2], vb, pa0, pa1, pa2, pa3);
#pragma unroll
  for (int r = 0; r < 16; ++r) p0[r] = fmaf(p0[r], C, mnC);
#pragma unroll
  for (int r = 0; r < 16; ++r) p1[r] = fmaf(p1[r], C, mnC);
  pv_one<3>(o[3], vb, pa0, pa1, pa2, pa3);
#pragma unroll
  for (int r = 0; r < 16; ++r) p0[r] = __builtin_amdgcn_exp2f(p0[r]);
}
template <int DKR, int LDQ, int LDK, int LDV, int LDO>
__device__ __forceinline__ void attn_unit(const bf16_t* __restrict__ Qb, const bf16_t* __restrict__ Kh, const bf16_t* __restrict__ Kr, const bf16_t* __restrict__ Vh,
                                          bf16_t* __restrict__ Ob, int seq, char* lds, int qpos0, const float* __restrict__ rtab64) {
  constexpr float SCALE = DKR ? 0.07216878364870322f : 0.08838834764831845f;
  int tid = threadIdx.x; asm volatile("" : "+v"(tid));
  const int wid = tid >> 6, lane = tid & 63, r32 = lane & 31, hi = lane >> 5;
  char* V_lds = lds + OFF_V; char* K_lds = lds + OFF_K; char* KR_lds = lds + OFF_KR; char* QR_lds = lds + OFF_QR + wid * QRW;
  float* ws = (float*)(lds + OFF_WS) + wid * 64; float* li_l = ws; float* al_l = ws + 32;
  float m_reg = -1e30f, l_reg = 0; f32x16 o[4] = {}; constexpr int NQ = DKR ? NQL : NQL0; bf16x8 qr[8 - NQ];
  const bf16_t* Qw = Qb + (long)(wid * QBLK + r32) * LDQ + hi * 8;
#pragma unroll
  for (int d0 = 0; d0 < 8 - NQ; ++d0) qr[d0] = *reinterpret_cast<const bf16x8*>(Qw + d0 * 16);
#pragma unroll
  for (int d0 = 8 - NQ; d0 < 8; ++d0) *reinterpret_cast<bf16x8*>(QR_lds + (d0 - (8 - NQ) + 4) * 1024 + lane * 16) = *reinterpret_cast<const bf16x8*>(Qw + d0 * 16);
  if constexpr (DKR > 0) {
    bf16x8 qf[4];
#pragma unroll
    for (int d0 = 0; d0 < 4; ++d0) qf[d0] = *reinterpret_cast<const bf16x8*>(Qw + 128 + d0 * 16);
    const int tpos = qpos0 + wid * QBLK + r32;
#pragma unroll
    for (int ax = 0; ax < 2; ++ax) { const int ipos = ax ? (tpos & 63) : (tpos >> 6);
#pragma unroll
      for (int e = 0; e < 8; e += 2) { float o1[2], o2[2];
        const float4 cst = *reinterpret_cast<const float4*>(rtab64 + (ipos * 16 + 8 * hi + e) * 2);
#pragma unroll
        for (int k = 0; k < 2; ++k) { const float cs = k ? cst.z : cst.x, sn = k ? cst.w : cst.y;
          const float x1 = __uint_as_float(((unsigned)(unsigned short)qf[2 * ax][e + k]) << 16), x2 = __uint_as_float(((unsigned)(unsigned short)qf[2 * ax + 1][e + k]) << 16);
          o1[k] = x1 * cs - x2 * sn; o2[k] = x1 * sn + x2 * cs; }
        const unsigned w1 = cvtpk(o1[0], o1[1]), w2 = cvtpk(o2[0], o2[1]);
        qf[2 * ax][e] = (short)(w1 & 0xffffu); qf[2 * ax][e + 1] = (short)(w1 >> 16); qf[2 * ax + 1][e] = (short)(w2 & 0xffffu); qf[2 * ax + 1][e + 1] = (short)(w2 >> 16); } }
#pragma unroll
    for (int d0 = 0; d0 < 4; ++d0) *reinterpret_cast<bf16x8*>(QR_lds + d0 * 1024 + lane * 16) = qf[d0];
  }
  const int sr = tid >> 4, sc = (tid & 15) * 8, vst0 = v_st(sr, sc), vst1 = v_st(32 + sr, sc);
  const int krr = tid >> 3, krc = (tid & 7) * 8;
  const int vb0 = (int)(uintptr_t)V_lds + v_rd_base(lane);
  constexpr int SD = DKR ? MLA_SD : 2;
  struct { bf16x8 vs0, vs1, ks0, ks1, kr; } sr_[SD];
#define SLOAD(i, k0) do { sr_[i].vs0 = *reinterpret_cast<const bf16x8*>(&Vh[(long)((k0) + sr) * LDV + sc]); sr_[i].vs1 = *reinterpret_cast<const bf16x8*>(&Vh[(long)((k0) + 32 + sr) * LDV + sc]); \
    sr_[i].ks0 = *reinterpret_cast<const bf16x8*>(&Kh[(long)((k0) + sr) * LDK + sc]); sr_[i].ks1 = *reinterpret_cast<const bf16x8*>(&Kh[(long)((k0) + 32 + sr) * LDK + sc]); \
    if constexpr (DKR > 0) sr_[i].kr = *reinterpret_cast<const bf16x8*>(&Kr[(long)((k0) + krr) * 64 + krc]); } while (0)
#define SWRITE(b, i) do { *(bf16x8*)(V_lds + (b) * SHM_V + vst0) = sr_[i].vs0;          \
    *(bf16x8*)(V_lds + (b) * SHM_V + vst1) = sr_[i].vs1; int kc = sc * 2;               \
    *(bf16x8*)(K_lds + (b) * SHM_K + KSWZ(sr, kc)) = sr_[i].ks0;                       \
    *(bf16x8*)(K_lds + (b) * SHM_K + KSWZ(32 + sr, kc)) = sr_[i].ks1;                  \
    if constexpr (DKR > 0) *(bf16x8*)(KR_lds + (b) * SHM_KR + KRSWZ(krr, krc * 2)) = sr_[i].kr; } while (0)
#define SWAIT() do { if constexpr (SD == 1) asm volatile("s_waitcnt vmcnt(0)" ::: "memory"); else asm volatile("s_waitcnt vmcnt(4)" ::: "memory"); } while (0)
#define RESC(a) do { if (__any((a) < 1.f)) { if (hi == 0) al_l[r32] = (a); asm volatile("s_waitcnt lgkmcnt(0)" ::: "memory"); \
    _Pragma("unroll") for (int d = 0; d < 4; ++d) _Pragma("unroll") for (int r = 0; r < 16; ++r) o[d][r] *= al_l[crow(r, hi)]; } } while (0)
  f32x16 pA0, pA1, pB0, pB1; float mnA, mnB, alA, alB; bf16x8 pa0, pa1, pa2, pa3; const int NT = seq / KVBLK;
  constexpr int SE = 0, SO = SD - 1;
  SLOAD(SE, 0); asm volatile("s_waitcnt vmcnt(0)" ::: "memory"); SWRITE(0, SE); __syncthreads();
  qkt<DKR, NQ>(pA0, pA1, K_lds, KR_lds, QR_lds, qr, r32, hi, lane); partialSM(pA0, pA1, m_reg, mnA, alA, SCALE);
  SLOAD(SO, KVBLK); if constexpr (SD == 2) { if (2 < NT) SLOAD(SE, 2 * KVBLK); }
  SWAIT(); SWRITE(1, SO); __syncthreads();
  for (int j = 1; j + 1 < NT; j += 2) {
    SBAR(); qkt<DKR, NQ>(pB0, pB1, K_lds + SHM_K, KR_lds + SHM_KR, QR_lds, qr, r32, hi, lane);
    finishSM(pA0, pA1, alA, l_reg, pa0, pa1, pa2, pa3); SBAR();
    SLOAD(SO, (j + SD) * KVBLK); SBAR();
    pv_sm(o, vb0, pa0, pa1, pa2, pa3, pB0, pB1, m_reg, mnB, alB, SCALE);
    __syncthreads(); SWAIT(); SWRITE(0, SE);
    RESC(alB); __syncthreads();
    SBAR(); qkt<DKR, NQ>(pA0, pA1, K_lds, KR_lds, QR_lds, qr, r32, hi, lane);
    finishSM(pB0, pB1, alB, l_reg, pa0, pa1, pa2, pa3); SBAR();
    if (SD == 1 || j + 3 < NT) SLOAD(SE, (j + 1 + SD) * KVBLK); SBAR();
    pv_sm(o, vb0 + (int)SHM_V, pa0, pa1, pa2, pa3, pA0, pA1, m_reg, mnA, alA, SCALE);
    __syncthreads(); SWAIT(); SWRITE(1, SO);
    RESC(alA); __syncthreads();
  }
  SBAR(); qkt<DKR, NQ>(pB0, pB1, K_lds + SHM_K, KR_lds + SHM_KR, QR_lds, qr, r32, hi, lane);
  finishSM(pA0, pA1, alA, l_reg, pa0, pa1, pa2, pa3); SBAR();
  pv_sm(o, vb0, pa0, pa1, pa2, pa3, pB0, pB1, m_reg, mnB, alB, SCALE);
  __syncthreads(); RESC(alB);
  finishSM(pB0, pB1, alB, l_reg, pa0, pa1, pa2, pa3); SBAR();
  pv_d0(o, vb0 + (int)SHM_V, pa0, pa1, pa2, pa3);
  if (hi == 0) li_l[r32] = l_reg; asm volatile("s_waitcnt lgkmcnt(0)" ::: "memory");
  float rli[16];
#pragma unroll
  for (int r = 0; r < 16; ++r) rli[r] = __builtin_amdgcn_rcpf(li_l[crow(r, hi)]);
  bf16_t* Ow = Ob + (long)(wid * QBLK) * LDO;
#pragma unroll
  for (int r = 0; r < 16; ++r) { int orow = crow(r, hi);
#pragma unroll
    for (int d0 = 0; d0 < 4; ++d0) Ow[(long)orow * LDO + d0 * 32 + r32] = (bf16_t)(cvtpk(o[d0][r] * rli[r], 0.f) & 0xffffu); }
  __syncthreads();
#undef SLOAD
#undef SWRITE
#undef SWAIT
#undef RESC
}
#undef SBAR
}
typedef pg8::bf16_t bf16_t;
typedef float f32x4 __attribute__((ext_vector_type(4)));
typedef unsigned v4u __attribute__((ext_vector_type(4)));
typedef unsigned v2u __attribute__((ext_vector_type(2)));
#define LAS __attribute__((address_space(3)))
constexpr int NWAVES = 8, NTHR = 512;
constexpr int DM = 2048, NB = 8, SEQ = 2048, CTX = 256, TK = SEQ + CTX  , MLAT = NB * SEQ  , MZ = NB * TK  ;
constexpr int DFF = 5632, NUP = 2 * DFF, NIN = 7168;
constexpr float EPS = 1e-6f;
constexpr size_t MiB = 1u << 20;
constexpr size_t WS_MODP = 0;
constexpr size_t WS_MOD  = 7 * MiB;
constexpr size_t WS_RT64 = 7 * MiB + 440 * 1024, WS_RT128 = WS_RT64 + 8192;
constexpr size_t WS_CTL  = 7 * MiB + 512 * 1024, CTL_BYTES = 16384;
constexpr size_t WS_WUP  = 8 * MiB;
constexpr size_t WS_WDN  = 52 * MiB;
constexpr size_t WS_Z    = 74 * MiB;
constexpr size_t WS_KA   = WS_Z, WS_VA = WS_Z + 36 * MiB, WS_MRG = WS_Z, WS_Z2 = WS_Z;
constexpr size_t WS_WIN  = 146 * MiB;
constexpr size_t WS_WKV  = 174 * MiB;
constexpr size_t WS_WQ   = 176 * MiB;
constexpr size_t WS_WBR  = 179 * MiB;
constexpr size_t WS_WOUT = 187 * MiB;
constexpr size_t WS_ACT  = 195 * MiB;
constexpr size_t WS_CKV  = WS_ACT;
constexpr size_t WS_CQ   = WS_ACT + 18 * MiB;
constexpr size_t WS_OA   = WS_ACT, WS_OB = WS_ACT + 32 * MiB;
constexpr size_t WS_KB   = WS_ACT + 64 * MiB;
constexpr size_t WS_VB   = WS_KB + 9 * MiB;
constexpr size_t WS_KPE  = WS_VB + 9 * MiB;
constexpr size_t WS_QB   = WS_KPE + 3 * MiB;
constexpr size_t WS_GATE = WS_QB + 32 * MiB;
constexpr size_t WS_QA   = WS_GATE + 128 * MiB;
constexpr size_t WS_ATT_END = WS_QA + 48 * MiB;
constexpr size_t WS_X1B = WS_ACT, WS_X2B = WS_Z;
constexpr size_t WS_PART = 146 * MiB, WS_RAWB = 152 * MiB;
constexpr size_t WS_H    = 322 * MiB;
constexpr size_t WS_END  = 498 * MiB;
static_assert(WS_ATT_END <= WS_END && WS_RAWB + 6 * MiB <= WS_H, "ws map");
constexpr int EX_OFF = 131072;
constexpr int MISC_OFF = 157696; constexpr int LDS_BYTES = 157696 + 256; static_assert(att::LDS_BYTES <= LDS_BYTES, "attention LDS");

#define XB_TMO      128
#define XB_XCNT(j)  (256  + 64 * (j))
#define XB_XSUB(j)  (1280 + 64 * (j))
#define XB_XGEN(j)  (2304 + 64 * (j))
#define XB_TOP      3328
#define XB_TOPGEN   3392
#define XCD_BAR_WORDS 3456
#define XB_SPIN_CAP (1u << 18)

__device__ __forceinline__ unsigned xb_ld(unsigned* p)              { return __hip_atomic_load(p, __ATOMIC_RELAXED, __HIP_MEMORY_SCOPE_AGENT); }
__device__ __forceinline__ unsigned xb_add(unsigned* p, unsigned v) { return __hip_atomic_fetch_add(p, v, __ATOMIC_RELAXED, __HIP_MEMORY_SCOPE_AGENT); }
__device__ __forceinline__ unsigned xb_xcc_id() { return (unsigned)__builtin_amdgcn_s_getreg((3 << 11) | 20) & 0xFu; }
#define XB_SPIN(cond, bar) do { unsigned _sp = 0; while (cond) { __builtin_amdgcn_s_sleep(1); \
    if ((++_sp & 255u) == 0u) { if (xb_ld(&(bar)[XB_TMO])) break; if (_sp > XB_SPIN_CAP) { atomicAdd(&(bar)[XB_TMO], 1u); break; } } } } while (0)

struct XcdBarrier {
    unsigned* bar; unsigned x;
    volatile LAS unsigned* st;
};

__device__ __forceinline__ XcdBarrier xcd_barrier_post(unsigned* bar, volatile LAS unsigned* st) {
    XcdBarrier b; b.bar = bar; b.x = xb_xcc_id(); b.st = st;
    if (threadIdx.x == 0) (void)xb_add(&bar[XB_XCNT(b.x)], 1u);
    return b;
}
__device__ __forceinline__ void xcd_barrier_complete(unsigned* bar, unsigned x, unsigned& nloc, unsigned& nx) {
    const unsigned G = gridDim.x * gridDim.y * gridDim.z;
    unsigned sum, cnt, mine, sp = 0u;
    for (;;) {
        sum = 0u; cnt = 0u; mine = 0u;
#pragma unroll
        for (unsigned j = 0; j < 16; ++j) { const unsigned c = xb_ld(&bar[XB_XCNT(j)]); sum += c; cnt += (c > 0u) ? 1u : 0u; mine = (j == x) ? c : mine; }
        if (sum == G) break;
        __builtin_amdgcn_s_sleep(1);
        if ((++sp & 255u) == 0u) { if (xb_ld(&bar[XB_TMO])) break; if (sp > XB_SPIN_CAP) { atomicAdd(&bar[XB_TMO], 1u); break; } }
    }
    nloc = mine > 0u ? mine : 1u; nx = cnt > 0u ? cnt : 1u;
}

__device__ __forceinline__ void xcd_barrier(const XcdBarrier& b) {
    asm volatile("s_waitcnt vmcnt(0)" ::: "memory");
    __syncthreads();
    if (threadIdx.x == 0) {
        unsigned* bar = b.bar;
        __builtin_amdgcn_s_waitcnt(0);
        unsigned nloc = b.st[0], nx = b.st[1];
        if (nloc == 0u) { xcd_barrier_complete(bar, b.x, nloc, nx); b.st[0] = nloc; b.st[1] = nx; }
        const unsigned old = xb_add(&bar[XB_XSUB(b.x)], 1u);
        const unsigned gen = old / nloc;
        if (old + 1u == (gen + 1u) * nloc) {
            __builtin_amdgcn_fence(__ATOMIC_RELEASE, "agent");
            asm volatile("s_waitcnt vmcnt(0)" ::: "memory");
            const unsigned og = xb_add(&bar[XB_TOP], 1u);
            const unsigned tg = og / nx;
            if (og + 1u == (tg + 1u) * nx) xb_add(&bar[XB_TOPGEN], 1u);
            else XB_SPIN(xb_ld(&bar[XB_TOPGEN]) == tg, bar);
            __builtin_amdgcn_fence(__ATOMIC_ACQUIRE, "agent");
            xb_add(&bar[XB_XGEN(b.x)], 1u);
            asm volatile("s_waitcnt vmcnt(0)" ::: "memory");
        } else {
            XB_SPIN(xb_ld(&bar[XB_XGEN(b.x)]) == gen, bar);
            __builtin_amdgcn_fence(__ATOMIC_ACQUIRE, "agent");
            asm volatile("s_waitcnt vmcnt(0)" ::: "memory");
        }
    }
    __syncthreads();
}

struct Args {
    const float *x, *c, *ctx, *c_ctx, *w_ada, *b_ada, *norm1_g, *w_in, *mla_q_norm_g, *w_q_up, *mla_kv_norm_g, *w_kv_up, *gqa_q_norm_g, *gqa_k_norm_g,
                *w_br_a, *w_br_b, *w_out, *norm2_g, *w_up, *conv_w, *conv_b, *w_down, *final_norm_g;
    float* out; unsigned char* ws;
};
__device__ __forceinline__ unsigned f2bf(float f) { unsigned u = __builtin_bit_cast(unsigned, f); return (u + 0x7fffu + ((u >> 16) & 1u)) >> 16; }
__device__ __forceinline__ unsigned pk2(float lo, float hi) { return f2bf(lo) | (f2bf(hi) << 16); }
__device__ __forceinline__ float blo(unsigned w) { return __uint_as_float(w << 16); }
__device__ __forceinline__ float bhi(unsigned w) { return __uint_as_float(w & 0xffff0000u); }
__device__ __forceinline__ float wave_sum(float v) {
#pragma unroll
    for (int o = 1; o < 64; o <<= 1) v += __shfl_xor(v, o);
    return v;
}
__device__ __forceinline__ void transpose_item(const float* W, int N, bf16_t* WT, int Kdst, int koff, int k0, int n0, int drow0, const float* kscale, LAS float* scr, int lane) {
    float tv[32];
#pragma unroll
    for (int i = 0; i < 32; ++i) { const int kk = 2 * i + (lane >> 5); tv[i] = __builtin_nontemporal_load(W + (size_t)(k0 + kk) * N + n0 + (lane & 31)); }
#pragma unroll
    for (int i = 0; i < 32; ++i) { const int kk = 2 * i + (lane >> 5); float v = tv[i]; if (kscale) v *= kscale[k0 + kk]; scr[kk * 33 + (lane & 31)] = v; }
    asm volatile("s_waitcnt lgkmcnt(0)" ::: "memory");
    const int c = lane & 7;
#pragma unroll
    for (int j = 0; j < 4; ++j) { const int n = (lane >> 3) + 8 * j; const LAS float* s = scr + (8 * c) * 33 + n;
        v4u o; o.x = pk2(s[0 * 33], s[1 * 33]); o.y = pk2(s[2 * 33], s[3 * 33]); o.z = pk2(s[4 * 33], s[5 * 33]); o.w = pk2(s[6 * 33], s[7 * 33]);
        *(v4u*)(WT + (size_t)(drow0 + n) * Kdst + koff + k0 + 8 * c) = o; }
    asm volatile("s_waitcnt lgkmcnt(0)" ::: "memory");
}
__device__ __forceinline__ int win_map(int n0) {
    if (n0 < 512) return n0;
    if (n0 < 576) return 1024 + (n0 - 512);
    if (n0 < 832) return 512 + (n0 - 576);
    if (n0 < 1088) return 768 + (n0 - 832);
    if (n0 < 2880) return n0 + 192;
    { const int gi = n0 - 2880, half = gi >= 2048 ? 1 : 0, ch = gi - half * 2048; return 3072 + (ch >> 7) * 256 + half * 128 + (ch & 127); }
}
__device__ __forceinline__ int up_map(int n0) { const int ch = n0 < 5632 ? n0 : n0 - 5632; return (ch >> 7) * 256 + (n0 < 5632 ? 0 : 128) + (ch & 127); }
__device__ __forceinline__ void row_norm_mod(const float* xrow, bf16_t* orow, const float* g, const LAS float* SH, const LAS float* SC, int lane) {
    const f32x4* xr = (const f32x4*)xrow + lane; f32x4 v[8]; float s = 0.f;
#pragma unroll
    for (int j = 0; j < 8; ++j) { v[j] = __builtin_nontemporal_load(xr + 64 * j); s += (v[j].x * v[j].x + v[j].y * v[j].y) + (v[j].z * v[j].z + v[j].w * v[j].w); }
    const float rstd = 1.0f / sqrtf(wave_sum(s) * (1.f / 2048.f) + EPS);
    v2u* o8 = (v2u*)orow + lane;
#pragma unroll
    for (int j = 0; j < 8; ++j) { const int cidx = (lane + 64 * j) * 4; const f32x4 gg = *(const f32x4*)(g + cidx);
        const float a0 = (v[j].x * rstd * gg.x) * (1.f + SC[cidx]) + SH[cidx], a1 = (v[j].y * rstd * gg.y) * (1.f + SC[cidx + 1]) + SH[cidx + 1];
        const float a2 = (v[j].z * rstd * gg.z) * (1.f + SC[cidx + 2]) + SH[cidx + 2], a3 = (v[j].w * rstd * gg.w) * (1.f + SC[cidx + 3]) + SH[cidx + 3];
        v2u w; w.x = pk2(a0, a1); w.y = pk2(a2, a3); o8[64 * j] = w; }
}
__device__ __forceinline__ void row_norm_mod_bf(const bf16_t* xrow, bf16_t* orow, const float* g, const LAS float* SH, const LAS float* SC, int lane) {
    const v4u* xr = (const v4u*)xrow + lane; v4u w[4]; float s = 0.f;
#pragma unroll
    for (int j = 0; j < 4; ++j) { w[j] = xr[64 * j];
#pragma unroll
        for (int e = 0; e < 4; ++e) { const float a = blo(w[j][e]), c = bhi(w[j][e]); s += a * a + c * c; } }
    const float rstd = 1.0f / sqrtf(wave_sum(s) * (1.f / 2048.f) + EPS);
    v4u* o16 = (v4u*)orow + lane;
#pragma unroll
    for (int j = 0; j < 4; ++j) { const int cidx = (lane + 64 * j) * 8; v4u o;
#pragma unroll
        for (int e = 0; e < 4; ++e) { const int c0 = cidx + 2 * e;
            const float a0 = (blo(w[j][e]) * rstd * g[c0]) * (1.f + SC[c0]) + SH[c0], a1 = (bhi(w[j][e]) * rstd * g[c0 + 1]) * (1.f + SC[c0 + 1]) + SH[c0 + 1];
            o[e] = pk2(a0, a1); }
        o16[64 * j] = o; }
}
__device__ __forceinline__ void row_norm_mod_bf2(const bf16_t* xa, bf16_t* oa, const bf16_t* xb, bf16_t* ob, const float* g, const LAS float* SH, const LAS float* SC, int lane) {
    const v4u* pa = (const v4u*)xa + lane; const v4u* pb = (const v4u*)xb + lane; v4u wa[4], wb[4]; float sa = 0.f, sb = 0.f;
#pragma unroll
    for (int j = 0; j < 4; ++j) { wa[j] = pa[64 * j]; wb[j] = pb[64 * j]; }
#pragma unroll
    for (int j = 0; j < 4; ++j)
#pragma unroll
        for (int e = 0; e < 4; ++e) { const float a = blo(wa[j][e]), c = bhi(wa[j][e]), a2 = blo(wb[j][e]), c2 = bhi(wb[j][e]); sa += a * a + c * c; sb += a2 * a2 + c2 * c2; }
#pragma unroll
    for (int o = 1; o < 64; o <<= 1) { sa += __shfl_xor(sa, o); sb += __shfl_xor(sb, o); }
    const float ra = 1.0f / sqrtf(sa * (1.f / 2048.f) + EPS), rb = 1.0f / sqrtf(sb * (1.f / 2048.f) + EPS);
    v4u* qa = (v4u*)oa + lane; v4u* qb = (v4u*)ob + lane;
#pragma unroll
    for (int j = 0; j < 4; ++j) { const int cidx = (lane + 64 * j) * 8; v4u o0, o1;
#pragma unroll
        for (int e = 0; e < 4; ++e) { const int c0 = cidx + 2 * e; const float g0 = g[c0], g1 = g[c0 + 1], m0 = 1.f + SC[c0], m1 = 1.f + SC[c0 + 1], h0 = SH[c0], h1 = SH[c0 + 1];
            o0[e] = pk2((blo(wa[j][e]) * ra * g0) * m0 + h0, (bhi(wa[j][e]) * ra * g1) * m1 + h1);
            o1[e] = pk2((blo(wb[j][e]) * rb * g0) * m0 + h0, (bhi(wb[j][e]) * rb * g1) * m1 + h1); }
        qa[64 * j] = o0; qb[64 * j] = o1; }
}
struct Rope { float c0, s0, c1, s1; };
__device__ __forceinline__ Rope rope_setup(int w, int R, int grow, int gcol, const float* tab) {
    const int q = R / 4, d = 2 * w, axis = d / (2 * q), j = d & (q - 1);
    const int ipos = axis ? gcol : grow;
    const f32x4 cst = *(const f32x4*)(tab + (ipos * q + j) * 2);
    Rope r; r.c0 = cst[0]; r.s0 = cst[1]; r.c1 = cst[2]; r.s1 = cst[3];
    const bool x2 = (d & q) != 0; if (!x2) { r.s0 = -r.s0; r.s1 = -r.s1; }
    return r;
}
#ifndef REP0
#define REP0 1
#endif
#ifndef REP2
#define REP2 1
#endif
#ifndef REP6
#define REP6 1
#endif
__global__ void __launch_bounds__(NTHR, 2) fwd_megakernel(Args A) {
    extern __shared__ __attribute__((aligned(16))) unsigned char lds_raw[];
    cg::grid_group grid = cg::this_grid();
    LAS unsigned char* lds = (LAS unsigned char*)lds_raw;
    const int G = gridDim.x, blk = blockIdx.x, NGW = G * NWAVES;
    { volatile LAS unsigned* mz = (volatile LAS unsigned*)(lds + MISC_OFF); if (threadIdx.x < 64) mz[threadIdx.x] = 0u; }
    __syncthreads();
    grid.sync();
    const XcdBarrier bar = xcd_barrier_post((unsigned*)(A.ws + WS_CTL), (volatile LAS unsigned*)(lds + MISC_OFF) + 8);
#define PHASE_IDS int tid = threadIdx.x; asm volatile("" : "+v"(tid)); const int lane = tid & 63, wave = __builtin_amdgcn_readfirstlane(tid >> 6), gw = blk * NWAVES + wave; (void)lane; (void)gw;
    unsigned char* ws = A.ws;
    float* MODP = (float*)(ws + WS_MODP); float* MOD = (float*)(ws + WS_MOD); float* RT64 = (float*)(ws + WS_RT64); float* RT128 = (float*)(ws + WS_RT128);
    bf16_t* WUP = (bf16_t*)(ws + WS_WUP); bf16_t* WDN = (bf16_t*)(ws + WS_WDN); bf16_t* Z = (bf16_t*)(ws + WS_Z);
    bf16_t* WIN = (bf16_t*)(ws + WS_WIN); bf16_t* WKV = (bf16_t*)(ws + WS_WKV); bf16_t* WQ = (bf16_t*)(ws + WS_WQ); bf16_t* WBR = (bf16_t*)(ws + WS_WBR); bf16_t* WOUT = (bf16_t*)(ws + WS_WOUT);
    bf16_t* CKV = (bf16_t*)(ws + WS_CKV); bf16_t* CQ = (bf16_t*)(ws + WS_CQ); bf16_t* OA = (bf16_t*)(ws + WS_OA); bf16_t* OB = (bf16_t*)(ws + WS_OB); bf16_t* KBm = (bf16_t*)(ws + WS_KB); bf16_t* VBm = (bf16_t*)(ws + WS_VB);
    bf16_t* KPE = (bf16_t*)(ws + WS_KPE); bf16_t* QB = (bf16_t*)(ws + WS_QB); bf16_t* GATE = (bf16_t*)(ws + WS_GATE); bf16_t* QA = (bf16_t*)(ws + WS_QA);
    bf16_t* KA = (bf16_t*)(ws + WS_KA); bf16_t* VA = (bf16_t*)(ws + WS_VA); bf16_t* MRG = (bf16_t*)(ws + WS_MRG); bf16_t* Z2 = (bf16_t*)(ws + WS_Z2);
    bf16_t* X1B = (bf16_t*)(ws + WS_X1B); bf16_t* X2B = (bf16_t*)(ws + WS_X2B);
    float* PART = (float*)(ws + WS_PART); float* RAWB = (float*)(ws + WS_RAWB); bf16_t* H = (bf16_t*)(ws + WS_H);

#if !defined(ONLY) || ONLY==0
    _Pragma("unroll 1") for (int rep0 = 0; rep0 < REP0; ++rep0) {
        PHASE_IDS
        LAS float* S = (LAS float*)lds;
        LAS float* R = (LAS float*)(lds + 8192);
        for (int item = blk; item < 16 * 48; item += G) {
            const int kc = item / 48, nc = item % 48;
            for (int idx = tid; idx < 9 * 128; idx += NTHR) { const int cn = idx >> 7, k = kc * 128 + (idx & 127); const float v = cn < 8 ? A.c[cn * 2048 + k] : A.c_ctx[k]; S[idx] = v / (1.f + __expf(-v)); }
            __syncthreads();
            const int col4 = tid & 63, ks = tid >> 6;
            f32x4 acc[9];
#pragma unroll
            for (int cn = 0; cn < 9; ++cn) acc[cn] = (f32x4){0.f, 0.f, 0.f, 0.f};
            const f32x4* wp = (const f32x4*)(A.w_ada + (size_t)(kc * 128 + ks * 16) * 12288 + nc * 256) + col4;
#pragma unroll 4
            for (int kk = 0; kk < 16; ++kk) { const f32x4 w = __builtin_nontemporal_load(wp + (size_t)kk * 3072);
#pragma unroll
                for (int cn = 0; cn < 9; ++cn) acc[cn] += S[cn * 128 + ks * 16 + kk] * w; }
#pragma unroll
            for (int cn = 0; cn < 9; ++cn) ((LAS f32x4*)R)[(ks * 9 + cn) * 64 + col4] = acc[cn];
            __syncthreads();
            for (int o = tid; o < 9 * 256; o += NTHR) { const int cn = o >> 8, cc = o & 255; float s = 0.f;
#pragma unroll
                for (int k2 = 0; k2 < 8; ++k2) s += R[(k2 * 9 + cn) * 256 + cc];
                MODP[(size_t)(kc * 9 + cn) * 12288 + nc * 256 + cc] = s; }
            __syncthreads();
        }
        LAS float* scr = (LAS float*)(lds + wave * 16384);
        constexpr int I_IN = 32 * 218, I_KV = 8 * 64, I_Q = 12 * 48, I_BR = 16 * 64, I_OUT = 32 * 64, I_UP = 32 * 352, I_DN = 88 * 64;
        constexpr int NITEMS = I_IN + I_KV + I_Q;
        for (int it = gw; it < NITEMS; it += NGW) {
            int r = it;
            if (r < I_IN) { const int nb = r % 218, kb = r / 218; transpose_item(A.w_in, 6976, WIN, 2048, 0, kb * 64, nb * 32, win_map(nb * 32), nullptr, scr, lane); continue; } r -= I_IN;
            if (r < I_KV) { const int nb = r % 64, kb = r / 64; transpose_item(A.w_kv_up, 2048, WKV, 512, 0, kb * 64, nb * 32, nb * 32, A.mla_kv_norm_g, scr, lane); continue; } r -= I_KV;
            { const int nb = r % 48, kb = r / 48; transpose_item(A.w_q_up, 1536, WQ, 768, 0, kb * 64, nb * 32, nb * 32, A.mla_q_norm_g, scr, lane); }
        }
        for (int i = blk * NTHR + tid; i < 64 * 16 + 64 * 32; i += G * NTHR) {
            const bool big = i >= 64 * 16; const int k = big ? i - 64 * 16 : i, q = big ? 32 : 16, pos = k / q, j = k - pos * q;
            float sn, cs; sincosf((float)pos * exp2f(-(float)j * (13.287712379549449f / (float)q)), &sn, &cs);
            float* tp = (big ? RT128 : RT64) + (size_t)k * 2; tp[0] = cs; tp[1] = sn; }
        for (int i = blk * NTHR + tid; i < 192 * 2048 / 8; i += G * NTHR) *(v4u*)(WIN + (size_t)1088 * 2048 + (size_t)i * 8) = (v4u){0u, 0u, 0u, 0u};
        if (REP0 > 1) __syncthreads();
    }
#endif
    xcd_barrier(bar);

#if !defined(ONLY) || ONLY==1
    {
        PHASE_IDS
        LAS float* SH = (LAS float*)lds; LAS float* SC = SH + 2048;
        const bool is_ctx = blk >= 224; const int cn = is_ctx ? 8 : blk / 28, bi = is_ctx ? blk - 224 : blk % 28;
        {
            float sv8[8];
#pragma unroll
            for (int q = 0; q < 8; ++q) sv8[q] = A.b_ada[tid + q * NTHR];
#pragma unroll
            for (int kc = 0; kc < 16; ++kc)
#pragma unroll
                for (int q = 0; q < 8; ++q) sv8[q] += MODP[(size_t)(kc * 9 + cn) * 12288 + tid + q * NTHR];
#pragma unroll
            for (int q = 0; q < 8; ++q) SH[tid + q * NTHR] = sv8[q];
        }
        for (int idx = blk * 432 + tid; idx < (blk + 1) * 432; idx += NTHR) { const int c2 = idx / 12288, col = idx % 12288; float s = A.b_ada[col];
#pragma unroll
            for (int kc = 0; kc < 16; ++kc) s += MODP[(size_t)(kc * 9 + c2) * 12288 + col];
            MOD[idx] = s; }
        __syncthreads();
        if (!is_ctx) { for (int t = bi * 8 + wave; t < SEQ; t += 28 * 8) row_norm_mod(A.x + ((size_t)cn * SEQ + t) * DM, Z + ((size_t)cn * TK + CTX + t) * DM, A.norm1_g, SH, SC, lane); }
        else { for (int cr = bi * 8 + wave; cr < NB * CTX; cr += 32 * 8) { const int b = cr >> 8, j = cr & 255; row_norm_mod(A.ctx + (size_t)cr * DM, Z + ((size_t)b * TK + j) * DM, A.norm1_g, SH, SC, lane); } }
    }
#endif
    xcd_barrier(bar);

#if !defined(ONLY) || ONLY==2
    _Pragma("unroll 1") for (int rep2 = 0; rep2 < REP2; ++rep2) {
        pg8::Gemm g{Z, WIN, MZ, NIN, DM}; pg8::ProjOrder S; S.init(G, blk);
        pg8::EpiProj E{CKV, KBm, VBm, KPE, CQ, QB, GATE};
        pg8::gemm_phase<pg8::EpiProj, pg8::ProjOrder, true, true>(lds, g, S, E);
        const int nfull = 1832 - 7 * G;
        if (G == 256 && blk >= nfull) { PHASE_IDS
            LAS float* scr = (LAS float*)(lds + wave * 16384);
            constexpr int I_UP = 32 * 352, I_DN = 88 * 64;
            const int nw = (G - nfull) * NWAVES;
            for (int it = (blk - nfull) * NWAVES + wave; it < I_UP + I_DN + 4096; it += nw) {
                if (it < I_UP) { const int nb = it % 352, kb = it / 352; transpose_item(A.w_up, 11264, WUP, 2048, 0, kb * 64, nb * 32, up_map(nb * 32), nullptr, scr, lane); }
                else if (it < I_UP + I_DN) { const int r = it - I_UP; const int nb = r % 64, kb = r / 64; transpose_item(A.w_down, 2048, WDN, 5632, 0, kb * 64, nb * 32, nb * 32, nullptr, scr, lane); }
                else { int r = it - I_UP - I_DN; const int which = r / 1024; r -= which * 1024; const int nb = r % 64, kb = r / 64;
                    if (which == 0) transpose_item(A.w_br_a, 2048, WBR, 2048, 0, kb * 64, nb * 32, nb * 32, nullptr, scr, lane);
                    else if (which == 1) transpose_item(A.w_br_b, 2048, WBR, 2048, 1024, kb * 64, nb * 32, nb * 32, nullptr, scr, lane);
                    else transpose_item(A.w_out, 2048, WOUT, 2048, 0, (kb + (which - 2) * 16) * 64, nb * 32, nb * 32, nullptr, scr, lane); }
            }
        } else if (G != 256) { PHASE_IDS
            LAS float* scr = (LAS float*)(lds + wave * 16384);
            constexpr int I_UP = 32 * 352, I_DN = 88 * 64;
            for (int it = gw; it < I_UP + I_DN + 4096; it += NGW) {
                if (it < I_UP) { const int nb = it % 352, kb = it / 352; transpose_item(A.w_up, 11264, WUP, 2048, 0, kb * 64, nb * 32, up_map(nb * 32), nullptr, scr, lane); }
                else if (it < I_UP + I_DN) { const int r = it - I_UP; const int nb = r % 64, kb = r / 64; transpose_item(A.w_down, 2048, WDN, 5632, 0, kb * 64, nb * 32, nb * 32, nullptr, scr, lane); }
                else { int r = it - I_UP - I_DN; const int which = r / 1024; r -= which * 1024; const int nb = r % 64, kb = r / 64;
                    if (which == 0) transpose_item(A.w_br_a, 2048, WBR, 2048, 0, kb * 64, nb * 32, nb * 32, nullptr, scr, lane);
                    else if (which == 1) transpose_item(A.w_br_b, 2048, WBR, 2048, 1024, kb * 64, nb * 32, nb * 32, nullptr, scr, lane);
                    else transpose_item(A.w_out, 2048, WOUT, 2048, 0, (kb + (which - 2) * 16) * 64, nb * 32, nb * 32, nullptr, scr, lane); }
            }
        }
    }
#endif
    xcd_barrier(bar);

#if !defined(ONLY) || ONLY==3
    { PHASE_IDS
    const float gk0 = A.gqa_k_norm_g[2 * lane], gk1 = A.gqa_k_norm_g[2 * lane + 1], gq0 = A.gqa_q_norm_g[2 * lane], gq1 = A.gqa_q_norm_g[2 * lane + 1];
    for (int rz = gw; rz < MZ; rz += NGW) {
        const int b = rz / TK, j = rz - b * TK; const bool lat = j >= CTX; const int t = j - CTX, grow = t >> 6, gcol = t & 63;
        unsigned* pckv = (unsigned*)(CKV + (size_t)rz * 512) + lane; unsigned* pkb = (unsigned*)(KBm + (size_t)rz * 256) + lane; unsigned* pkpe = (unsigned*)(KPE + (size_t)rz * 64) + (lane & 31);
        const size_t rl = (size_t)b * SEQ + (lat ? t : 0);
        unsigned* pcq = (unsigned*)(CQ + rl * 768) + lane; unsigned* pqb = (unsigned*)(QB + rl * 1024) + lane;
        unsigned wckv[4], wkb[2], wkpe, wcq[6], wqb[8];
#pragma unroll
        for (int i = 0; i < 4; ++i) wckv[i] = pckv[64 * i];
#pragma unroll
        for (int hh = 0; hh < 2; ++hh) wkb[hh] = pkb[64 * hh];
        wkpe = *pkpe;
        if (lat) {
#pragma unroll
            for (int i = 0; i < 6; ++i) wcq[i] = pcq[64 * i];
#pragma unroll
            for (int hh = 0; hh < 8; ++hh) wqb[hh] = pqb[64 * hh];
        } else {
#pragma unroll
            for (int i = 0; i < 6; ++i) wcq[i] = 0u;
#pragma unroll
            for (int hh = 0; hh < 8; ++hh) wqb[hh] = 0u;
        }
        Rope r128 = {1.f, 0.f, 1.f, 0.f}, r64 = {1.f, 0.f, 1.f, 0.f};
        if (lat) { r128 = rope_setup(lane, 128, grow, gcol, RT128); r64 = rope_setup(lane & 31, 64, grow, gcol, RT64); }
        float sv[12];
        sv[0] = 0.f;
#pragma unroll
        for (int i = 0; i < 4; ++i) { const float a = blo(wckv[i]), c = bhi(wckv[i]); sv[0] += a * a + c * c; }
#pragma unroll
        for (int hh = 0; hh < 2; ++hh) { const float a = blo(wkb[hh]), c = bhi(wkb[hh]); sv[1 + hh] = a * a + c * c; }
        sv[3] = 0.f;
#pragma unroll
        for (int i = 0; i < 6; ++i) { const float a = blo(wcq[i]), c = bhi(wcq[i]); sv[3] += a * a + c * c; }
#pragma unroll
        for (int hh = 0; hh < 8; ++hh) { const float a = blo(wqb[hh]), c = bhi(wqb[hh]); sv[4 + hh] = a * a + c * c; }
#pragma unroll
        for (int o = 1; o < 64; o <<= 1) {
#pragma unroll
            for (int q = 0; q < 12; ++q) sv[q] += __shfl_xor(sv[q], o); }
        { const float rstd = 1.0f / sqrtf(sv[0] * (1.f / 512.f) + EPS);
#pragma unroll
            for (int i = 0; i < 4; ++i) pckv[64 * i] = pk2(blo(wckv[i]) * rstd, bhi(wckv[i]) * rstd); }
#pragma unroll
        for (int hh = 0; hh < 2; ++hh) { const float rstd = 1.0f / sqrtf(sv[1 + hh] * (1.f / 128.f) + EPS);
            const float a = blo(wkb[hh]) * rstd * gk0, c = bhi(wkb[hh]) * rstd * gk1; const float pa = __shfl_xor(a, 16), pc = __shfl_xor(c, 16);
            pkb[64 * hh] = pk2(a * r128.c0 + pa * r128.s0, c * r128.c1 + pc * r128.s1); }
        { const float a = blo(wkpe), c = bhi(wkpe); const float pa = __shfl_xor(a, 8), pc = __shfl_xor(c, 8);
            if (lat && lane < 32) *pkpe = pk2(a * r64.c0 + pa * r64.s0, c * r64.c1 + pc * r64.s1); }
        if (lat) {
            { const float rstd = 1.0f / sqrtf(sv[3] * (1.f / 768.f) + EPS);
#pragma unroll
                for (int i = 0; i < 6; ++i) pcq[64 * i] = pk2(blo(wcq[i]) * rstd, bhi(wcq[i]) * rstd); }
#pragma unroll
            for (int hh = 0; hh < 8; ++hh) { const float rstd = 1.0f / sqrtf(sv[4 + hh] * (1.f / 128.f) + EPS);
                const float a = blo(wqb[hh]) * rstd * gq0, c = bhi(wqb[hh]) * rstd * gq1; const float pa = __shfl_xor(a, 16), pc = __shfl_xor(c, 16);
                pqb[64 * hh] = pk2(a * r128.c0 + pa * r128.s0, c * r128.c1 + pc * r128.s1); }
        }
    }
    }
#endif
    xcd_barrier(bar);

#if !defined(ONLY) || ONLY==4
    {
        const int xc = blk & 7, jc = blk >> 3;
        { pg8::Gemm g{CQ, WQ, MLAT, 1536, 768}; pg8::ListOrder S{jc < 8 ? jc * 3 : 24 + (jc - 8), jc < 8 ? 3 : 1, 8, xc * 8};
          pg8::EpiPlain E{QA, 1536};
          pg8::gemm_phase<pg8::EpiPlain, pg8::ListOrder, true, true>(lds, g, S, E); }
        if (jc >= 8) { pg8::Gemm g{CKV, WKV, MZ, 2048, 512}; pg8::ListOrder S{(jc - 8) * 3, 3, 9, xc * 9};
          pg8::EpiKV E{KA, VA};
          pg8::gemm_phase<pg8::EpiKV, pg8::ListOrder, true, true>(lds, g, S, E); }
    }
#endif
    xcd_barrier(bar);

#if !defined(ONLY) || ONLY==6
    _Pragma("unroll 1") for (int rep6 = 0; rep6 < REP6; ++rep6) {
        const int b = blk & 7, jc = blk >> 3, qb = jc & 7; char* al = (char*)lds_raw;
        const size_t qrow = (size_t)b * SEQ + qb * 256, krow = (size_t)b * TK;
#if !defined(ATTV) || ATTV==0
#pragma unroll 1
        for (int i = 0; i < 2; ++i) { const int h = (jc >> 3) + 4 * i;
            att::attn_unit<64, 1536, 1024, 1024, 2048>(QA + qrow * 1536 + h * 192, KA + krow * 1024 + h * 128, KPE + krow * 64, VA + krow * 1024 + h * 128, OA + qrow * 2048 + h * 128, TK, al, qb * 256, RT64); }
#endif
#if !defined(ATTV) || ATTV==1
#pragma unroll 1
        for (int i = 0; i < 2; ++i) { const int h = (jc >> 3) + 4 * i, kvh = h >> 2;
            att::attn_unit<0, 1024, 256, 256, 2048>(QB + qrow * 1024 + h * 128, KBm + krow * 256 + kvh * 128, nullptr, VBm + krow * 256 + kvh * 128, OA + qrow * 2048 + 1024 + h * 128, TK, al, qb * 256, RT64); }
#endif
    }
#endif
    xcd_barrier(bar);

#if !defined(ONLY) || ONLY==7
    {
        pg8::StaticOrder S; S.init(MLAT, DM, G, blk);
        { pg8::Gemm g{OA, WBR, MLAT, DM, DM}; pg8::EpiBrH E{GATE, MRG}; pg8::gemm_phase<pg8::EpiBrH, pg8::StaticOrder, true, true>(lds, g, S, E); }
    }
#endif
    xcd_barrier(bar);

#if !defined(ONLY) || ONLY==8
    {
        pg8::Gemm g{MRG, WOUT, MLAT, DM, DM}; pg8::StaticOrder S; S.init(MLAT, DM, G, blk);
        pg8::EpiResB<float> E{A.x, X1B, MOD + 4096};
        pg8::gemm_phase<pg8::EpiResB<float>, pg8::StaticOrder, true, true>(lds, g, S, E);
    }
#endif
    xcd_barrier(bar);

#if !defined(ONLY) || ONLY==9
    {
        PHASE_IDS
        LAS float* SH = (LAS float*)lds; LAS float* SC = SH + 2048;
        const int nper = G / 8, cn = blk / nper, bi = blk % nper;
        for (int idx = tid; idx < 4096; idx += NTHR) SH[idx] = MOD[(size_t)cn * 12288 + 6144 + idx];
        __syncthreads();
        if (cn < 8) { const int st = nper * 8;
            for (int t = bi * 8 + wave; t + 3 * st < SEQ; t += 4 * st) {
                v4u w[4][4]; float sq[4];
#pragma unroll
                for (int q = 0; q < 4; ++q) { const v4u* xq = (const v4u*)(X1B + ((size_t)cn * SEQ + t + q * st) * DM) + lane;
#pragma unroll
                    for (int j = 0; j < 4; ++j) w[q][j] = xq[64 * j]; }
#pragma unroll
                for (int q = 0; q < 4; ++q) { float a2 = 0.f;
#pragma unroll
                    for (int j = 0; j < 4; ++j)
#pragma unroll
                        for (int e = 0; e < 4; ++e) { const float a = blo(w[q][j][e]), c = bhi(w[q][j][e]); a2 += a * a + c * c; }
                    sq[q] = a2; }
#pragma unroll
                for (int o = 1; o < 64; o <<= 1) {
#pragma unroll
                    for (int q = 0; q < 4; ++q) sq[q] += __shfl_xor(sq[q], o); }
                float rs[4];
#pragma unroll
                for (int q = 0; q < 4; ++q) rs[q] = 1.0f / sqrtf(sq[q] * (1.f / 2048.f) + EPS);
#pragma unroll
                for (int j = 0; j < 4; ++j) { const int cidx = (lane + 64 * j) * 8; float g8[8], m8[8], h8[8];
#pragma unroll
                    for (int e = 0; e < 8; ++e) { g8[e] = A.norm2_g[cidx + e]; m8[e] = 1.f + SC[cidx + e]; h8[e] = SH[cidx + e]; }
#pragma unroll
                    for (int q = 0; q < 4; ++q) { v4u o;
#pragma unroll
                        for (int e = 0; e < 4; ++e) o[e] = pk2((blo(w[q][j][e]) * rs[q] * g8[2 * e]) * m8[2 * e] + h8[2 * e], (bhi(w[q][j][e]) * rs[q] * g8[2 * e + 1]) * m8[2 * e + 1] + h8[2 * e + 1]);
                        *((v4u*)(Z2 + ((size_t)cn * SEQ + t + q * st) * DM) + lane + 64 * j) = o; }
                    asm volatile("" ::: "memory"); }
            }
            if (SEQ % (4 * st) != 0) for (int t = bi * 8 + wave + (SEQ / (4 * st)) * 4 * st; t < SEQ; t += st) row_norm_mod_bf(X1B + ((size_t)cn * SEQ + t) * DM, Z2 + ((size_t)cn * SEQ + t) * DM, A.norm2_g, SH, SC, lane); }
    }
#endif
    xcd_barrier(bar);

#if !defined(ONLY) || ONLY==10
    {
        pg8::Gemm g{Z2, WUP, MLAT, NUP, DM}; pg8::StaticOrder S; S.init(MLAT, NUP, G, blk);
        pg8::EpiUpConv E{H, A.conv_w, A.conv_b, PART, RAWB, (LAS float*)(lds + EX_OFF)};
        pg8::gemm_phase<pg8::EpiUpConv, pg8::StaticOrder, true, true>(lds, g, S, E);
    }
#endif
    xcd_barrier(bar);
#if !defined(ONLY) || ONLY==11
    { PHASE_IDS
    for (int it = gw; it < 112 * 22; it += NGW) {
        const int rowi = it / 22, cc = it - rowi * 22, b = rowi / 14, k = rowi - b * 14, jb = k >> 1, s = k & 1;
        const int pm = 8 * b + jb + s, side = s ? 0 : 1, nb = s ? pm - 1 : pm + 1, tap = s ? 0 : 2;
        const int ch = cc * 256 + lane * 4, pn = ch >> 7, cl = ch & 127, col = pn * 256 + cl;
        const float* pp = PART + (size_t)(pm * 2 + side) * 11264 + col; const float* rp = RAWB + (size_t)(nb * 2 + (1 - side)) * 11264 + col;
        const f32x4 ca = *(const f32x4*)pp + *(const f32x4*)(A.conv_w + (size_t)tap * 11264 + ch) * *(const f32x4*)rp;
        const f32x4 cbv = *(const f32x4*)(pp + 128) + *(const f32x4*)(A.conv_w + (size_t)tap * 11264 + 5632 + ch) * *(const f32x4*)(rp + 128);
        const f32x4 h = pg8::silu4(ca) * cbv;
        v2u w; w.x = pk2(h[0], h[1]); w.y = pk2(h[2], h[3]);
        *(v2u*)(H + (size_t)(pm * 256 + (side ? 255 : 0)) * DFF + ch) = w;
    }
    }
#endif
    xcd_barrier(bar);

#if !defined(ONLY) || ONLY==12
    {
        pg8::Gemm g{H, WDN, MLAT, DM, DFF}; pg8::StaticOrder S; S.init(MLAT, DM, G, blk);
        pg8::EpiResB<bf16_t> E{X1B, X2B, MOD + 10240};
        pg8::gemm_phase<pg8::EpiResB<bf16_t>, pg8::StaticOrder, true, true>(lds, g, S, E);
    }
#endif
    xcd_barrier(bar);

#if !defined(ONLY) || ONLY==13
    { PHASE_IDS
    for (int r0 = gw; r0 < MLAT; r0 += 4 * NGW) {
        v4u w[4][4]; float sq[4];
#pragma unroll
        for (int q = 0; q < 4; ++q) { const v4u* xq = (const v4u*)(X2B + (size_t)(r0 + q * NGW) * DM) + lane;
#pragma unroll
            for (int j = 0; j < 4; ++j) w[q][j] = __builtin_nontemporal_load(xq + 64 * j); }
#pragma unroll
        for (int q = 0; q < 4; ++q) { float a2 = 0.f;
#pragma unroll
            for (int j = 0; j < 4; ++j)
#pragma unroll
                for (int e = 0; e < 4; ++e) { const float a = blo(w[q][j][e]), c = bhi(w[q][j][e]); a2 += a * a + c * c; }
            sq[q] = a2; }
#pragma unroll
        for (int o = 1; o < 64; o <<= 1) {
#pragma unroll
            for (int q = 0; q < 4; ++q) sq[q] += __shfl_xor(sq[q], o); }
#pragma unroll
        for (int q = 0; q < 4; ++q) { const float rs = 1.0f / sqrtf(sq[q] * (1.f / 2048.f) + EPS);
#pragma unroll
            for (int j = 0; j < 4; ++j) { const int cidx = (lane + 64 * j) * 8; const f32x4 g0 = *(const f32x4*)(A.final_norm_g + cidx), g1 = *(const f32x4*)(A.final_norm_g + cidx + 4);
                f32x4 o0, o1; o0[0] = blo(w[q][j][0]); o0[1] = bhi(w[q][j][0]); o0[2] = blo(w[q][j][1]); o0[3] = bhi(w[q][j][1]); o1[0] = blo(w[q][j][2]); o1[1] = bhi(w[q][j][2]); o1[2] = blo(w[q][j][3]); o1[3] = bhi(w[q][j][3]);
                f32x4* op = (f32x4*)(A.out + (size_t)(r0 + q * NGW) * DM + cidx); __builtin_nontemporal_store(o0 * rs * g0, op); __builtin_nontemporal_store(o1 * rs * g1, op + 1); } }
    }
    }
#endif
}

extern "C" void kernel_launch(void* const* d_in, const int* in_sizes, int n_in, void* d_out, int out_size, void* d_ws, size_t ws_size, hipStream_t stream) {
    static int grid = 0;
    if (grid == 0) {
        if (n_in != 23 || out_size != MLAT * DM || ws_size < WS_END) { fprintf(stderr, "kernel_launch: unexpected shapes n_in %d out %d ws %zu (need %zu)\n", n_in, out_size, ws_size, (size_t)WS_END); grid = -1; return; }
        int dev = 0, cus = 0, per_cu = 0;
        hipGetDevice(&dev); hipDeviceGetAttribute(&cus, hipDeviceAttributeMultiprocessorCount, dev);
        if (hipFuncSetAttribute((const void*)fwd_megakernel, hipFuncAttributeMaxDynamicSharedMemorySize, LDS_BYTES) != hipSuccess) { fprintf(stderr, "kernel_launch: hipFuncSetAttribute failed\n"); grid = -1; return; }
        if (hipOccupancyMaxActiveBlocksPerMultiprocessor(&per_cu, (const void*)fwd_megakernel, NTHR, LDS_BYTES) != hipSuccess || per_cu < 1) { fprintf(stderr, "kernel_launch: occupancy query failed (%d)\n", per_cu); grid = -1; return; }
        grid = cus;
        if (grid != 256) fprintf(stderr, "kernel_launch: %d CUs; this kernel's schedules assume 256\n", grid);
    }
    if (grid < 0) return;
    if (hipMemsetAsync((char*)d_ws + WS_CTL, 0, CTL_BYTES, stream) != hipSuccess) { fprintf(stderr, "kernel_launch: memset failed\n"); return; }
    Args a{};
    const float** ap = (const float**)&a;
    for (int i = 0; i < 23; ++i) ap[i] = (const float*)d_in[i];
    a.out = (float*)d_out; a.ws = (unsigned char*)d_ws;
    void* args[] = {&a};
    hipError_t e = hipLaunchCooperativeKernel((const void*)fwd_megakernel, dim3(grid), dim3(NTHR), args, LDS_BYTES, stream);
    if (e != hipSuccess) fprintf(stderr, "cooperative launch failed: %s (grid %d)\n", hipGetErrorString(e), grid);
}
```
